# Optimizing an MI355X kernel written in HIP

```python
import math
import jax, jax.numpy as jnp
from jax import lax
import numpy as np

D_MODEL = 1024
BATCH = 8
SEQ = 4096
DEPTH = 2

CHUNK = 64

MIX_WIDTH = D_MODEL
GROUP_WIDTH = MIX_WIDTH // 4
HEAD_DIM = 64
EPS = 1e-6

SSM_WIDTH = GROUP_WIDTH
SSM_CH_PER_GROUP = 16
SSM_GROUPS = SSM_WIDTH // SSM_CH_PER_GROUP
SSM_STATE = 64
DT_MIN = 1e-3
DT_MAX = 1e-1

POOL_WIDTH = GROUP_WIDTH
POOL_WINDOWS = (2, 4, 8, 16)
POOL_CH = POOL_WIDTH // len(POOL_WINDOWS)

FOX_HEADS = GROUP_WIDTH // HEAD_DIM
FOX_WIDTH = FOX_HEADS * HEAD_DIM
Q_BLOCK = 128

MEM_LEN = 256
MEM_HEADS = 4
MEM_WIDTH = MEM_HEADS * HEAD_DIM

N_EXPERTS = 32
TOP_K = 4
D_EXPERT = D_MODEL
SWIGLU_LIMIT = 7.0
SWIGLU_ALPHA = 1.702
MOE_BLOCK = 128

OFF_A = 0
OFF_B = OFF_A + SSM_WIDTH
OFF_Q = OFF_B + POOL_WIDTH
OFF_K = OFF_Q + FOX_WIDTH
OFF_V = OFF_K + FOX_WIDTH
OFF_F = OFF_V + FOX_WIDTH
OFF_QM = OFF_F + FOX_HEADS
IN_COLS = OFF_QM + MEM_WIDTH

kernel_name = 'hybrid_s5_pool_fox_mem_moe_block'


def rms_norm(x, g):
    xf = x.astype(jnp.float32)
    y = xf * lax.rsqrt(jnp.mean(xf * xf, axis=-1, keepdims=True) + EPS)
    return (y * g.astype(jnp.float32)).astype(x.dtype)


def s5_mixer(u, lam_re, lam_im, log_dt, b_re, b_im, c_re, c_im, d, glu_w, glu_b):
    bsz, seq, _ = u.shape
    f32 = jnp.float32
    uf = u.astype(f32).reshape(bsz, seq, SSM_GROUPS, SSM_CH_PER_GROUP)
    lr = lam_re.astype(f32)
    li = lam_im.astype(f32)
    dt = jnp.exp(log_dt.astype(f32))[:, None]
    mag = jnp.exp(lr * dt)
    a_re = mag * jnp.cos(li * dt)
    a_im = mag * jnp.sin(li * dt)
    den = lr * lr + li * li
    n_re = a_re - 1.0
    n_im = a_im
    k_re = (n_re * lr + n_im * li) / den
    k_im = (n_im * lr - n_re * li) / den
    br = b_re.astype(f32)
    bi = b_im.astype(f32)
    bb_re = k_re[..., None] * br - k_im[..., None] * bi
    bb_im = k_re[..., None] * bi + k_im[..., None] * br
    x_re = jnp.einsum('blgh,gph->blgp', uf, bb_re)
    x_im = jnp.einsum('blgh,gph->blgp', uf, bb_im)
    a_re_t = jnp.broadcast_to(a_re, (1, seq) + a_re.shape)
    a_im_t = jnp.broadcast_to(a_im, (1, seq) + a_im.shape)

    def combine(e1, e2):
        a1r, a1i, b1r, b1i = e1
        a2r, a2i, b2r, b2i = e2
        return (a2r * a1r - a2i * a1i,
                a2r * a1i + a2i * a1r,
                a2r * b1r - a2i * b1i + b2r,
                a2r * b1i + a2i * b1r + b2i)

    _, _, h_re, h_im = lax.associative_scan(combine, (a_re_t, a_im_t, x_re, x_im), axis=1)
    y = (jnp.einsum('blgp,ghp->blgh', h_re, c_re.astype(f32))
         - jnp.einsum('blgp,ghp->blgh', h_im, c_im.astype(f32))
         + d.astype(f32) * uf)
    z = jax.nn.gelu(y.reshape(bsz, seq, SSM_WIDTH))
    out = z * jax.nn.sigmoid(z @ glu_w.astype(f32) + glu_b.astype(f32))
    return out.astype(u.dtype)


def pool_mixer(v, pool_w):
    bsz, seq, _ = v.shape
    vg = v.astype(jnp.float32).reshape(bsz, seq, len(POOL_WINDOWS), POOL_CH)
    cs0 = jnp.pad(jnp.cumsum(vg, axis=1), ((0, 0), (1, 0), (0, 0), (0, 0)))
    pos = jnp.arange(1, seq + 1, dtype=jnp.float32)[None, :, None]
    outs = []
    for gi, w in enumerate(POOL_WINDOWS):
        upper = cs0[:, 1:, gi]
        lower = jnp.pad(cs0[:, :seq + 1 - w, gi], ((0, 0), (w - 1, 0), (0, 0)))
        mean = (upper - lower) / jnp.minimum(pos, float(w))
        outs.append((mean - vg[:, :, gi]) @ pool_w[gi].astype(jnp.float32))
    return jnp.concatenate(outs, axis=-1).astype(v.dtype)


def fox_attention(q, k, v, f_logit, forget_b, q_g, k_g):
    bsz, seq = q.shape[0], q.shape[1]
    q = rms_norm(q, q_g)
    k = rms_norm(k, k_g)
    log_f = jax.nn.log_sigmoid(f_logit.astype(jnp.float32) + forget_b.astype(jnp.float32))
    c = jnp.moveaxis(jnp.cumsum(log_f, axis=1), 1, 2)
    scale = HEAD_DIM ** -0.5
    outs = []
    for blk in range(seq // Q_BLOCK):
        q0 = blk * Q_BLOCK
        q1 = q0 + Q_BLOCK
        s = jnp.einsum('bqhd,bkhd->bhqk', q[:, q0:q1], k[:, :q1],
                       preferred_element_type=jnp.float32) * scale
        s = s + (c[:, :, q0:q1, None] - c[:, :, None, :q1])
        mask = jnp.arange(q0, q1)[:, None] >= jnp.arange(q1)[None, :]
        s = jnp.where(mask, s, -jnp.inf)
        p = jax.nn.softmax(s, axis=-1).astype(v.dtype)
        outs.append(jnp.einsum('bhqk,bkhd->bqhd', p, v[:, :q1]))
    return jnp.concatenate(outs, axis=1).reshape(bsz, seq, FOX_WIDTH)


def memory_attention(qm, mem_k, mem_v, q_g, k_g):
    bsz, seq = qm.shape[0], qm.shape[1]
    qm = rms_norm(qm, q_g)
    mk = rms_norm(mem_k, k_g)
    s = jnp.einsum('blhd,bmhd->bhlm', qm, mk, preferred_element_type=jnp.float32) * (HEAD_DIM ** -0.5)
    p = jax.nn.softmax(s, axis=-1).astype(mem_v.dtype)
    return jnp.einsum('bhlm,bmhd->blhd', p, mem_v).reshape(bsz, seq, MEM_WIDTH)


def moe_ffn(h, router_w, router_b, w_gate, b_gate, w_up, b_up, w_down, b_down):
    bsz, seq, dm = h.shape
    n_tok = bsz * seq
    ht = h.reshape(n_tok, dm)
    logits = (ht @ router_w + router_b).astype(jnp.float32)
    top_val, top_idx = lax.top_k(logits, TOP_K)
    gates = jax.nn.softmax(top_val, axis=-1)
    n = n_tok * TOP_K
    flat_e = top_idx.reshape(n)
    flat_tok = jnp.arange(n, dtype=jnp.int32) // TOP_K
    flat_g = gates.reshape(n)
    order = jnp.argsort(flat_e)
    sorted_e = flat_e[order]
    counts = jnp.bincount(flat_e, length=N_EXPERTS)
    padded = (counts + MOE_BLOCK - 1) // MOE_BLOCK * MOE_BLOCK
    start = jnp.cumsum(counts) - counts
    pad_end = jnp.cumsum(padded)
    pad_start = pad_end - padded
    dest = pad_start[sorted_e] + jnp.arange(n, dtype=jnp.int32) - start[sorted_e]
    cap = n + N_EXPERTS * MOE_BLOCK
    n_blocks = cap // MOE_BLOCK
    buf_tok = jnp.zeros((cap,), jnp.int32).at[dest].set(flat_tok[order])
    buf_gate = jnp.zeros((cap,), jnp.float32).at[dest].set(flat_g[order])
    block_e = jnp.minimum(
        jnp.searchsorted(pad_end, jnp.arange(n_blocks, dtype=jnp.int32) * MOE_BLOCK, side='right'),
        N_EXPERTS - 1)

    def run_block(args):
        tok, g, e = args
        xb = ht[tok]
        gl = xb @ w_gate[e] + b_gate[e]
        up = xb @ w_up[e] + b_up[e]
        gl = jnp.minimum(gl, SWIGLU_LIMIT)
        up = jnp.clip(up, -SWIGLU_LIMIT, SWIGLU_LIMIT)
        act = gl * jax.nn.sigmoid(SWIGLU_ALPHA * gl)
        y = ((up + 1.0) * act) @ w_down[e] + b_down[e]
        return y * g[:, None].astype(y.dtype)

    ys = lax.map(run_block, (buf_tok.reshape(n_blocks, MOE_BLOCK),
                             buf_gate.reshape(n_blocks, MOE_BLOCK), block_e))
    out = jnp.zeros((n_tok, dm), ys.dtype).at[buf_tok].add(ys.reshape(cap, dm))
    return out.reshape(bsz, seq, dm).astype(h.dtype)


def hybrid_layer(x, mem, mix_norm_g, w_in, ssm_lambda_re, ssm_lambda_im, ssm_log_dt,
                 ssm_b_re, ssm_b_im, ssm_c_re, ssm_c_im, ssm_d, ssm_glu_w, ssm_glu_b, ssm_out_g,
                 pool_w, pool_scale, fox_forget_b, fox_q_g, fox_k_g, fox_out_g,
                 mem_norm_g, mem_w_kv, mem_q_g, mem_k_g, mem_out_g, w_out,
                 ffn_norm_g, router_w, router_b, exp_w_gate, exp_b_gate, exp_w_up, exp_b_up,
                 exp_w_down, exp_b_down):
    bsz, seq, _ = x.shape
    h = rms_norm(x, mix_norm_g)
    proj = h @ w_in
    u_a = proj[..., OFF_A:OFF_B]
    u_b = proj[..., OFF_B:OFF_Q]
    q = proj[..., OFF_Q:OFF_K].reshape(bsz, seq, FOX_HEADS, HEAD_DIM)
    k = proj[..., OFF_K:OFF_V].reshape(bsz, seq, FOX_HEADS, HEAD_DIM)
    v = proj[..., OFF_V:OFF_F].reshape(bsz, seq, FOX_HEADS, HEAD_DIM)
    f_logit = proj[..., OFF_F:OFF_QM]
    qm = proj[..., OFF_QM:IN_COLS].reshape(bsz, seq, MEM_HEADS, HEAD_DIM)

    y_a = s5_mixer(u_a, ssm_lambda_re, ssm_lambda_im, ssm_log_dt, ssm_b_re, ssm_b_im,
                   ssm_c_re, ssm_c_im, ssm_d, ssm_glu_w, ssm_glu_b)
    y_b = pool_mixer(u_b, pool_w)
    y_c = fox_attention(q, k, v, f_logit, fox_forget_b, fox_q_g, fox_k_g)
    kv = rms_norm(mem, mem_norm_g) @ mem_w_kv
    n_mem = mem.shape[1]
    mem_k = kv[..., :MEM_WIDTH].reshape(bsz, n_mem, MEM_HEADS, HEAD_DIM)
    mem_v = kv[..., MEM_WIDTH:].reshape(bsz, n_mem, MEM_HEADS, HEAD_DIM)
    y_m = memory_attention(qm, mem_k, mem_v, mem_q_g, mem_k_g)

    merged = jnp.concatenate([rms_norm(y_a, ssm_out_g), rms_norm(y_b, pool_scale),
                              rms_norm(y_c, fox_out_g), rms_norm(y_m, mem_out_g)], axis=-1)
    x = x + merged @ w_out
    x = x + moe_ffn(rms_norm(x, ffn_norm_g), router_w, router_b, exp_w_gate, exp_b_gate,
                    exp_w_up, exp_b_up, exp_w_down, exp_b_down)
    return x


def setup_inputs(seed: int = 0) -> dict:
    key = jax.random.key(seed)
    ks = iter(jax.random.split(key, 48))
    f32 = jnp.float32

    def normal(shape, scale):
        return jax.random.normal(next(ks), shape, f32) * scale

    def gain(shape):
        return 1.0 + normal(shape, 0.02)

    L = DEPTH
    x = normal((BATCH, SEQ, D_MODEL), 1.0)
    mem = normal((BATCH, MEM_LEN, D_MODEL), 1.0)
    mix_norm_g = gain((L, D_MODEL))
    w_in = normal((L, D_MODEL, IN_COLS), D_MODEL ** -0.5)
    ssm_lambda_re = -0.5 + normal((L, SSM_GROUPS, SSM_STATE), 0.01)
    ssm_lambda_im = jnp.pi * jnp.arange(SSM_STATE, dtype=f32) + normal((L, SSM_GROUPS, SSM_STATE), 0.01)
    ssm_log_dt = jax.random.uniform(next(ks), (L, SSM_GROUPS), f32, math.log(DT_MIN), math.log(DT_MAX))
    ssm_b_re = normal((L, SSM_GROUPS, SSM_STATE, SSM_CH_PER_GROUP), (2.0 * SSM_CH_PER_GROUP) ** -0.5)
    ssm_b_im = normal((L, SSM_GROUPS, SSM_STATE, SSM_CH_PER_GROUP), (2.0 * SSM_CH_PER_GROUP) ** -0.5)
    ssm_c_re = normal((L, SSM_GROUPS, SSM_CH_PER_GROUP, SSM_STATE), (2.0 * SSM_STATE) ** -0.5)
    ssm_c_im = normal((L, SSM_GROUPS, SSM_CH_PER_GROUP, SSM_STATE), (2.0 * SSM_STATE) ** -0.5)
    ssm_d = normal((L, SSM_GROUPS, SSM_CH_PER_GROUP), 1.0)
    ssm_glu_w = normal((L, SSM_WIDTH, SSM_WIDTH), SSM_WIDTH ** -0.5)
    ssm_glu_b = normal((L, SSM_WIDTH), 0.02)
    ssm_out_g = gain((L, SSM_WIDTH))
    pool_w = normal((L, len(POOL_WINDOWS), POOL_CH, POOL_CH), POOL_CH ** -0.5)
    pool_scale = gain((L, POOL_WIDTH))
    fox_forget_b = 3.0 + normal((L, FOX_HEADS), 0.5)
    fox_q_g = gain((L, HEAD_DIM))
    fox_k_g = gain((L, HEAD_DIM))
    fox_out_g = gain((L, FOX_WIDTH))
    mem_norm_g = gain((L, D_MODEL))
    mem_w_kv = normal((L, D_MODEL, 2 * MEM_WIDTH), D_MODEL ** -0.5)
    mem_q_g = gain((L, HEAD_DIM))
    mem_k_g = gain((L, HEAD_DIM))
    mem_out_g = gain((L, MEM_WIDTH))
    w_out = normal((L, MIX_WIDTH, D_MODEL), MIX_WIDTH ** -0.5)
    ffn_norm_g = gain((L, D_MODEL))
    router_w = normal((L, D_MODEL, N_EXPERTS), D_MODEL ** -0.5)
    router_b = normal((L, N_EXPERTS), 0.01)
    exp_w_gate = normal((L, N_EXPERTS, D_MODEL, D_EXPERT), D_MODEL ** -0.5)
    exp_b_gate = normal((L, N_EXPERTS, D_EXPERT), 0.01)
    exp_w_up = normal((L, N_EXPERTS, D_MODEL, D_EXPERT), D_MODEL ** -0.5)
    exp_b_up = normal((L, N_EXPERTS, D_EXPERT), 0.01)
    exp_w_down = normal((L, N_EXPERTS, D_EXPERT, D_MODEL), D_EXPERT ** -0.5)
    exp_b_down = normal((L, N_EXPERTS, D_MODEL), 0.01)
    return {'x': x, 'mem': mem, 'mix_norm_g': mix_norm_g, 'w_in': w_in,
            'ssm_lambda_re': ssm_lambda_re, 'ssm_lambda_im': ssm_lambda_im, 'ssm_log_dt': ssm_log_dt,
            'ssm_b_re': ssm_b_re, 'ssm_b_im': ssm_b_im, 'ssm_c_re': ssm_c_re, 'ssm_c_im': ssm_c_im,
            'ssm_d': ssm_d, 'ssm_glu_w': ssm_glu_w, 'ssm_glu_b': ssm_glu_b, 'ssm_out_g': ssm_out_g,
            'pool_w': pool_w, 'pool_scale': pool_scale,
            'fox_forget_b': fox_forget_b, 'fox_q_g': fox_q_g, 'fox_k_g': fox_k_g, 'fox_out_g': fox_out_g,
            'mem_norm_g': mem_norm_g, 'mem_w_kv': mem_w_kv, 'mem_q_g': mem_q_g, 'mem_k_g': mem_k_g,
            'mem_out_g': mem_out_g, 'w_out': w_out, 'ffn_norm_g': ffn_norm_g,
            'router_w': router_w, 'router_b': router_b,
            'exp_w_gate': exp_w_gate, 'exp_b_gate': exp_b_gate, 'exp_w_up': exp_w_up, 'exp_b_up': exp_b_up,
            'exp_w_down': exp_w_down, 'exp_b_down': exp_b_down}


def reference(x, mem, mix_norm_g, w_in, ssm_lambda_re, ssm_lambda_im, ssm_log_dt,
              ssm_b_re, ssm_b_im, ssm_c_re, ssm_c_im, ssm_d, ssm_glu_w, ssm_glu_b, ssm_out_g,
              pool_w, pool_scale, fox_forget_b, fox_q_g, fox_k_g, fox_out_g,
              mem_norm_g, mem_w_kv, mem_q_g, mem_k_g, mem_out_g, w_out,
              ffn_norm_g, router_w, router_b, exp_w_gate, exp_b_gate, exp_w_up, exp_b_up,
              exp_w_down, exp_b_down):
    for l in range(DEPTH):
        x = hybrid_layer(x, mem, mix_norm_g[l], w_in[l], ssm_lambda_re[l], ssm_lambda_im[l],
                         ssm_log_dt[l], ssm_b_re[l], ssm_b_im[l], ssm_c_re[l], ssm_c_im[l], ssm_d[l],
                         ssm_glu_w[l], ssm_glu_b[l], ssm_out_g[l], pool_w[l], pool_scale[l],
                         fox_forget_b[l], fox_q_g[l], fox_k_g[l], fox_out_g[l],
                         mem_norm_g[l], mem_w_kv[l], mem_q_g[l], mem_k_g[l], mem_out_g[l], w_out[l],
                         ffn_norm_g[l], router_w[l], router_b[l], exp_w_gate[l], exp_b_gate[l],
                         exp_w_up[l], exp_b_up[l], exp_w_down[l], exp_b_down[l])
    return x
```

```cpp
#include <hip/hip_runtime.h>
#include <hip/hip_bf16.h>
#include <cstdio>
#include <cstdint>
#include <cmath>

#ifndef MK_N_LAUNCHES
#define MK_N_LAUNCHES 1
#endif

#define LAS __attribute__((address_space(3)))
typedef unsigned short bf16_t;
typedef short bf16x8 __attribute__((ext_vector_type(8)));
typedef short s16x4 __attribute__((ext_vector_type(4)));
typedef float f32x2 __attribute__((ext_vector_type(2)));
typedef float f32x4 __attribute__((ext_vector_type(4)));
typedef float f32x16 __attribute__((ext_vector_type(16)));
typedef unsigned u32x2 __attribute__((ext_vector_type(2)));
typedef unsigned u32x4 __attribute__((ext_vector_type(4)));
typedef int i32x4v __attribute__((ext_vector_type(4)));

constexpr int NB = 8, SEQ = 4096, NTOK = NB * SEQ, DM = 1024, NLAYER = 2, INC = 1540;
constexpr int NE = 32, TOPK = 4, NROWS = NTOK * TOPK, CAP = NROWS + NE * 256;
constexpr int NCHUNK = NTOK / 64, KSSM = 1152, MEMLEN = 256, NMEM = NB * MEMLEN;
constexpr float EPS = 1e-6f, LOG2E = 1.4426950408889634f, C2 = 0.125f * 1.4426950408889634f;
constexpr int NWAVES = 8, NTHR = 512;

constexpr size_t MiB = 1u << 20;
constexpr size_t WS_CTL = 0, CTL_ZERO_BYTES = 64 * 1024;
constexpr size_t WS_WIN = 1 * MiB;
constexpr size_t WS_WKV = 7 * MiB;
constexpr size_t WS_WOUT = 9 * MiB;
constexpr size_t WS_WR = 13 * MiB;
constexpr size_t WS_WGLU = 14 * MiB;
constexpr size_t WS_WPOOL = 14 * MiB + 256 * 1024;
constexpr size_t WS_WF = 14 * MiB + 512 * 1024;
constexpr size_t WS_WSSM = 16 * MiB;
constexpr size_t WS_GSSM = 88 * MiB;
constexpr size_t WS_MEMB = 104 * MiB;
constexpr size_t WS_KVRAW = 108 * MiB;
constexpr size_t WS_MK = 112 * MiB;
constexpr size_t WS_MV = 114 * MiB;
constexpr size_t WS_SMALL = 116 * MiB;
constexpr size_t WS_RINV = WS_SMALL;
constexpr size_t WS_RINV2 = WS_RINV + 128 * 1024;
constexpr size_t WS_RINVM = WS_RINV2 + 128 * 1024;
constexpr size_t WS_FLOG = WS_RINVM + 64 * 1024;
constexpr size_t WS_CK = WS_FLOG + 512 * 1024;
constexpr size_t WS_SSQ = WS_CK + 512 * 1024;
constexpr size_t WS_SSQ2 = WS_SSQ + 2 * MiB;
constexpr size_t WS_LOGIT = WS_SSQ2 + 2 * MiB;
constexpr size_t WS_TKIDX = WS_LOGIT + 4 * MiB;
constexpr size_t WS_TKGATE = WS_TKIDX + 512 * 1024;
constexpr size_t WS_TKRANK = WS_TKGATE + 512 * 1024;
constexpr size_t WS_HIST = WS_TKRANK + 512 * 1024;
constexpr size_t WS_ROWTOK = WS_HIST + 64 * 1024;
constexpr size_t WS_ROWDST = WS_ROWTOK + 576 * 1024;
constexpr size_t WS_ROWGATE = WS_ROWDST + 576 * 1024;
constexpr size_t WS_ROWRINV = WS_ROWGATE + 576 * 1024;
static_assert(WS_ROWRINV + 576 * 1024 <= 132 * MiB, "small region");
constexpr size_t WS_XB = 132 * MiB;
constexpr size_t WS_WGU = 196 * MiB;
constexpr size_t WS_WD = 324 * MiB;
constexpr size_t WS_H = 388 * MiB;
constexpr size_t WS_X8 = WS_H + 144 * MiB;
constexpr size_t WS_MTAB = 600 * MiB;
constexpr size_t WS_LOGITP = 604 * MiB;
constexpr size_t WS_TGLIST = 616 * MiB;
constexpr float WSCALE = 64.0f, WUNSCALE = 1.0f / 64.0f;
constexpr float SLAB_SCALE = 16.0f, SLAB_UNSCALE = 1.0f / 16.0f;
constexpr size_t WS_ACT = 660 * MiB;
constexpr size_t WS_UEXT = WS_ACT;
constexpr size_t WS_UB = WS_ACT + 18 * MiB;
constexpr size_t WS_Q = WS_ACT + 34 * MiB;
constexpr size_t WS_K = WS_ACT + 50 * MiB;
constexpr size_t WS_V = WS_ACT + 66 * MiB;
constexpr size_t WS_QM = WS_ACT + 82 * MiB;
constexpr size_t WS_DP = WS_ACT + 98 * MiB;
constexpr size_t WS_Z = WS_ACT + 114 * MiB;
constexpr size_t WS_S = WS_ACT + 130 * MiB;
constexpr size_t WS_MERGED = WS_ACT + 134 * MiB;
constexpr size_t WS_SLAB = WS_ACT;
constexpr size_t WS_END = 916 * MiB;

constexpr int RING_BYTES = 131072;
constexpr int MISC_OFF = 135168;
constexpr int MOE_TAB_OFF = MISC_OFF + 256;
constexpr int GOFF_OFF = MISC_OFF + 2048;
constexpr int BIAS_OFF = MISC_OFF + 10240;
constexpr int GLU_TAB_OFF = MISC_OFF + 2048;
constexpr int LDS_BYTES = 147456;
static_assert(GLU_TAB_OFF + 4096 <= LDS_BYTES, "LDS map");

__device__ __forceinline__ unsigned f2bf(float f) { unsigned u = __builtin_bit_cast(unsigned, f); return (u + 0x7fffu + ((u >> 16) & 1u)) >> 16; }
typedef __bf16 bf16x2_hw __attribute__((ext_vector_type(2)));
__device__ __forceinline__ unsigned pk2(float lo, float hi) { const f32x2 v = {lo, hi}; return __builtin_bit_cast(unsigned, __builtin_convertvector(v, bf16x2_hw)); }
__device__ __forceinline__ float bflo(unsigned w) { return __builtin_bit_cast(float, w << 16); }
__device__ __forceinline__ float bfhi(unsigned w) { return __builtin_bit_cast(float, w & 0xffff0000u); }
__device__ __forceinline__ float wave_sum(float v) {
#pragma unroll
    for (int o = 1; o < 64; o <<= 1) v += __shfl_xor(v, o);
    return v;
}
__device__ __forceinline__ float fast_sigmoid(float x) { return __builtin_amdgcn_rcpf(1.0f + __builtin_amdgcn_exp2f(-x * LOG2E)); }
__device__ __forceinline__ float clamp448(float x) { return fminf(fmaxf(x, -448.0f), 448.0f); }
__device__ __forceinline__ unsigned pk4_fp8(float a, float b, float c, float d) { int w = 0; w = __builtin_amdgcn_cvt_pk_fp8_f32(clamp448(a), clamp448(b), w, false); w = __builtin_amdgcn_cvt_pk_fp8_f32(clamp448(c), clamp448(d), w, true); return (unsigned)w; }
#define LDS_WAIT() asm volatile("s_waitcnt lgkmcnt(0)" ::: "memory")
#define VM_WAIT() asm volatile("s_waitcnt vmcnt(0)" ::: "memory")

struct Args { const float* in[36]; float* out; unsigned char* ws; int ph_lo, ph_hi; };
enum { I_X = 0, I_MEM, I_MIXG, I_WIN, I_LRE, I_LIM, I_LDT, I_BRE, I_BIM, I_CRE, I_CIM, I_SD, I_GLUW, I_GLUB, I_SOUTG, I_POOLW, I_POOLS, I_FFB, I_FQG, I_FKG, I_FOUTG,
       I_MNG, I_MWKV, I_MQG, I_MKG, I_MOUTG, I_WOUT, I_FFNG, I_RW, I_RB, I_EWG, I_EBG, I_EWU, I_EBU, I_EWD, I_EBD };

namespace pg8 {
constexpr int BM = 256, BK = 64, HALF = 128, HTB = HALF * BK * 2, STAGE_BYTES = 8 * HTB, NXCD = 8, WGM = 8;
__device__ __forceinline__ int lds_byte(int r, int c) { const int st = (r >> 4) * 2 + (c >> 5), rr = r & 15, cc = c & 31, ob = rr * 64 + cc * 2; return st * 1024 + (ob ^ (((ob >> 9) & 1) << 5)); }
__device__ __forceinline__ void stage_rc(int b, int& R, int& C) { const int st = b / 1024, sb = b % 1024, swz = sb ^ (((sb >> 9) & 1) << 5); R = (st >> 1) * 16 + swz / 64; C = (st & 1) * 32 + (swz % 64) / 2; }
__device__ __forceinline__ int perm32(int rho) { const int n = rho >> 4, i = rho & 15; return 8 * (i >> 2) + 4 * n + (i & 3); }

struct Unit { int pm, pn, grp; };

__device__ __forceinline__ int xcd_remap(int wgid, int nwg) { const int q = nwg / NXCD, r = nwg % NXCD, xcd = wgid % NXCD, off = wgid / NXCD; return (xcd < r ? xcd * (q + 1) : r * (q + 1) + (xcd - r) * q) + off; }
__device__ __forceinline__ void tile_of(int w, int nM, int nN, int& pm, int& pn) { const int nig = WGM * nN, gid = w / nig, fm = gid * WGM, gsz = (nM - fm) < WGM ? (nM - fm) : WGM; pm = fm + ((w % nig) % gsz); pn = (w % nig) / gsz; }

struct DenseSched {
    static constexpr bool GATHER = false;
    const char* A; const char* B; int lda, ldb; size_t a_gs, b_gs; int nM, nN, tpg, nwg, G, c;
    __device__ __forceinline__ void init(const void* A_, int lda_, size_t a_gs_, const void* B_, int ldb_, size_t b_gs_, int M, int N, int ngroups, int G_, int c_) {
        A = (const char*)A_; B = (const char*)B_; lda = lda_; ldb = ldb_; a_gs = a_gs_; b_gs = b_gs_; nM = M / BM; nN = N / BM; tpg = nM * nN; nwg = tpg * ngroups; G = G_; c = c_; }
    __device__ __forceinline__ bool next(int i, Unit& u) const {
        const long L = (long)i * G + c; if (L >= nwg) return false;
        const int wgid = xcd_remap((int)L, nwg); u.grp = wgid / tpg; tile_of(wgid % tpg, nM, nN, u.pm, u.pn); return true; }
    __device__ __forceinline__ void bases(const Unit& u, const char*& a, const char*& b) const {
        a = A + (size_t)u.grp * a_gs + (size_t)u.pm * BM * lda * 2; b = B + (size_t)u.grp * b_gs + (size_t)u.pn * BM * ldb * 2; }
    __device__ __forceinline__ unsigned row_off(const Unit&, int) const { return 0u; }
    __device__ __forceinline__ void on_last(int) const {}
};
template <bool GATHER_> struct MoeSched {
    static constexpr bool GATHER = GATHER_;
    const char* A; const char* B; int lda, ldb; size_t b_es; int nN, n_mt, G, c, L0, Lend; const LAS unsigned char* mt_e; const int* row_tok; unsigned long long* note;
    __device__ __forceinline__ bool next(int i, Unit& u) const {
        const int nwg = n_mt * nN; const long L = (long)L0 + (long)i * G + c; if (L >= Lend) return false;
        const int wgid = xcd_remap((int)L, nwg); tile_of(wgid, n_mt, nN, u.pm, u.pn); u.grp = mt_e[u.pm]; return true; }
    __device__ __forceinline__ void bases(const Unit& u, const char*& a, const char*& b) const {
        a = GATHER ? A : A + (size_t)u.pm * BM * lda * 2; b = B + (size_t)u.grp * b_es + (size_t)u.pn * BM * ldb * 2; }
    __device__ __forceinline__ unsigned row_off(const Unit& u, int r) const { return (unsigned)row_tok[u.pm * BM + r] * (unsigned)(lda * 2); }
    __device__ __forceinline__ void on_last(int tid) const { if (note != nullptr && tid == 0) (void)__hip_atomic_fetch_add(note, 1ull << 32, __ATOMIC_RELAXED, __HIP_MEMORY_SCOPE_AGENT); }
};

typedef int i32x4 __attribute__((ext_vector_type(4)));
typedef int i32x8 __attribute__((ext_vector_type(8)));
__device__ __forceinline__ i32x8 cat8(bf16x8 lo, bf16x8 hi) { return __builtin_shufflevector(__builtin_bit_cast(i32x4, lo), __builtin_bit_cast(i32x4, hi), 0, 1, 2, 3, 4, 5, 6, 7); }
template <class T, class = void> struct has_pre { static constexpr bool value = false; };
template <class T> struct has_pre<T, decltype((void)sizeof(typename T::Pre))> { static constexpr bool value = true; };
struct NoPre {};
__device__ __forceinline__ void bias_dma(LAS unsigned char* lds, const float* src, int wid) { __builtin_amdgcn_global_load_lds((const unsigned*)src, (LAS unsigned*)(lds + BIAS_OFF + wid * 256), 4, 0, 0); }
template <int NY> __device__ __forceinline__ void bias_read(LAS unsigned char* lds, int wid, int fq, f32x4 (&b)[4]) {
    if constexpr (NY >= 0) asm volatile("s_waitcnt vmcnt(%0)" :: "n"(NY) : "memory");
#pragma unroll
    for (int j = 0; j < 4; ++j) b[j] = *(const LAS f32x4*)(lds + BIAS_OFF + wid * 256 + fq * 64 + j * 16);
}
template <class T, class = void> struct emin_of { static constexpr int value = 0; };
template <class T> struct emin_of<T, decltype((void)sizeof(char[T::EMIN]))> { static constexpr int value = T::EMIN; };
template <class T, bool = has_pre<T>::value> struct pre_of { typedef NoPre type; };
template <class T> struct pre_of<T, true> { typedef typename T::Pre type; };
template <class Epi, class Sched, bool FP8 = false>
__device__ __forceinline__ void gemm_phase(LAS unsigned char* lds, const int K, const Sched& S, const Epi& E) {
    int tid = threadIdx.x; asm volatile("" : "+v"(tid));
    const int wid = __builtin_amdgcn_readfirstlane(tid >> 6), lane = tid & 63, wr = wid >> 2, wc = wid & 3, fr = lane & 15, fq = lane >> 4;
    int Kv = K; asm volatile("" : "+s"(Kv));
    const int nt = Kv / BK;
    unsigned voffB[2], cOff[2][2];
#pragma unroll
    for (int i = 0; i < 2; ++i) { int sR, sC; stage_rc(tid * 16 + i * 8192, sR, sC); const int Rb = (int)Epi::PERM == 1 ? ((sR & ~31) + perm32(sR & 31)) : (int)Epi::PERM == 2 ? (64 * (sR >> 5) + 16 * ((sR >> 2) & 3) + 4 * ((sR >> 4) & 1) + (sR & 3)) : sR; voffB[i] = (unsigned)(Rb * S.ldb + sC) * 2u; }
    const size_t kstep = (size_t)(BK * 2);
    const size_t hstepB = (size_t)((int)Epi::PERM == 2 ? 8 : HALF) * S.ldb * 2;
    const unsigned ldsw = (unsigned)wid * 1024u;
    const int aoff = lds_byte(wr * 64 + fr, fq * 8), boff = lds_byte(wc * 32 + fr, fq * 8);
#define PG8_SA(b, h) (((b) * 2 + (h)) * HTB)
#define PG8_SB(b, h) ((4 + (b) * 2 + (h)) * HTB)
#define PG8_STAGE(bufoff, gbase, voff) do { _Pragma("unroll") for (int _i = 0; _i < 2; ++_i) { unsigned _vo = (voff)[_i]; asm volatile("" : "+v"(_vo));     \
        __builtin_amdgcn_global_load_lds((const unsigned*)((const char*)(gbase) + _vo), (LAS unsigned*)(lds + (bufoff) + ldsw + _i * 8192), 16, 0, 0); } } while (0)
#define PG8_AOFF(o, u) do { _Pragma("unroll") for (int _h = 0; _h < 2; ++_h) _Pragma("unroll") for (int _i = 0; _i < 2; ++_i) { int _r, _c; stage_rc(tid * 16 + _i * 8192, _r, _c); \
        if constexpr (Sched::GATHER) o[_h][_i] = S.row_off(u, _h * HALF + _r) + (unsigned)(_c * 2); else o[_h][_i] = (unsigned)((_h * HALF + _r) * S.lda + _c) * 2u; } } while (0)
#define PG8_GOFF(o, h_) do { _Pragma("unroll") for (int _i = 0; _i < 2; ++_i) { int _r, _c; stage_rc(tid * 16 + _i * 8192, _r, _c); \
        o[_i] = *(const LAS unsigned*)(lds + GOFF_OFF + wid * 1024 + ((h_) * 2 + _i) * 256 + lane * 4) * (unsigned)(S.lda * 2) + (unsigned)(_c * 2); } } while (0)
#define PG8_LDA(dst, b, h) do { _Pragma("unroll") for (int m = 0; m < 4; ++m) _Pragma("unroll") for (int k = 0; k < 2; ++k) dst[m][k] = *(const LAS bf16x8*)(lds + PG8_SA(b, h) + aoff + m * 2048 + k * 1024); } while (0)
#define PG8_LDB(dst, b, h) do { _Pragma("unroll") for (int n = 0; n < 2; ++n) _Pragma("unroll") for (int k = 0; k < 2; ++k) dst[n][k] = *(const LAS bf16x8*)(lds + PG8_SB(b, h) + boff + n * 2048 + k * 1024); } while (0)
#define PG8_MMA(ai, bj, At, Bt) do { __builtin_amdgcn_s_setprio(1); _Pragma("unroll") for (int m = 0; m < 4; ++m) _Pragma("unroll") for (int n = 0; n < 2; ++n) { \
        if constexpr (FP8) { asm volatile("v_mfma_scale_f32_16x16x128_f8f6f4 %0, %1, %2, %0, %3, %3 op_sel_hi:[0,0,0]" : "+v"(acc[ai][bj][m][n]) : "v"(cat8(Bt[n][0], Bt[n][1])), "v"(cat8(At[m][0], At[m][1])), "v"(fp8_unit_scale)); } \
        else { _Pragma("unroll") for (int k = 0; k < 2; ++k) acc[ai][bj][m][n] = __builtin_amdgcn_mfma_f32_16x16x32_bf16(Bt[n][k], At[m][k], acc[ai][bj][m][n], 0, 0, 0); } } \
        __builtin_amdgcn_s_setprio(0); } while (0)
#define PG8_WAIT_V(n) asm volatile("s_waitcnt vmcnt(" #n ")" ::: "memory")
#define PG8_WAIT_V8R(rel) do { if (emin_of<Epi>::value > 0 && (rel)) asm volatile("s_waitcnt vmcnt(%0)" :: "n"(8 + emin_of<Epi>::value) : "memory"); else asm volatile("s_waitcnt vmcnt(8)" ::: "memory"); } while (0)
#define PG8_WAIT_L(n) asm volatile("s_waitcnt lgkmcnt(" #n ")" ::: "memory")
#define PG8_BAR __builtin_amdgcn_s_barrier()
#define PG8_SCHED __builtin_amdgcn_sched_barrier(0)
    Unit cur, nxt; int ui = 0;
    if (!S.next(0, cur)) return;
    const int fp8_unit_scale = 0x7f7f7f7f;
    f32x4 acc[2][2][4][2];
    if constexpr (!has_pre<Epi>::value) {
#pragma unroll
    for (int a = 0; a < 2; ++a)
#pragma unroll
        for (int b = 0; b < 2; ++b)
#pragma unroll
            for (int m = 0; m < 4; ++m)
#pragma unroll
                for (int n = 0; n < 2; ++n) acc[a][b][m][n] = (f32x4){0.f, 0.f, 0.f, 0.f}; }
    bf16x8 At[4][2], B0[2][2], B1[2][2];
    const char* cA; const char* cB; S.bases(cur, cA, cB);
    PG8_AOFF(cOff, cur);
    PG8_STAGE(PG8_SB(0, 0), cB, voffB); PG8_STAGE(PG8_SB(0, 1), cB + hstepB, voffB); PG8_STAGE(PG8_SA(0, 0), cA, cOff[0]); PG8_STAGE(PG8_SA(0, 1), cA, cOff[1]);
    if (wr == 1) PG8_BAR;
    PG8_WAIT_V(2); PG8_BAR;
    PG8_STAGE(PG8_SB(1, 0), cB + kstep, voffB); PG8_STAGE(PG8_SA(1, 0), cA + kstep, cOff[0]); PG8_STAGE(PG8_SB(1, 1), cB + hstepB + kstep, voffB);
    PG8_WAIT_V(6); PG8_BAR;
    if constexpr (has_pre<Epi>::value) { E.pre_load(lds, cur, wid, wc, fr, fq); E.template pre_apply<0>(acc, lds, wid, fq); }
    for (;;) {
        const bool has_next = S.next(ui + 1, nxt);
        if (!has_next) S.on_last(tid);
        const char* nA = cA; const char* nB = cB;
        if (has_next) S.bases(nxt, nA, nB);
        if constexpr (has_pre<Epi>::value) { E.pre_load(lds, has_next ? nxt : cur, wid, wc, fr, fq); E.unit_top(lds, cur, wid, wr, lane); }
        if constexpr (Sched::GATHER) { {
#pragma unroll
            for (int h = 0; h < 2; ++h)
#pragma unroll
                for (int i = 0; i < 2; ++i) { int r_, c_; stage_rc(tid * 16 + i * 8192, r_, c_);
                    __builtin_amdgcn_global_load_lds((const unsigned*)(S.row_tok + (has_next ? nxt.pm : cur.pm) * BM + h * HALF + r_), (LAS unsigned*)(lds + GOFF_OFF + wid * 1024 + (h * 2 + i) * 256), 4, 0, 0); } } }
        for (int t = 0; t < nt; t += 2) {
            const bool last = (t == nt - 2);
            const char* a1 = cA + (size_t)(t + 1) * kstep;
            const char* a2 = last ? nA : cA + (size_t)(t + 2) * kstep; const char* b2 = last ? nB : cB + (size_t)(t + 2) * kstep;
            const char* a3 = a2 + kstep; const char* b3 = b2 + kstep;
            unsigned o20[2], o21[2];
#pragma unroll
            for (int i = 0; i < 2; ++i) { o20[i] = cOff[0][i]; o21[i] = cOff[1][i]; }
            if constexpr (Sched::GATHER) { if (last) { PG8_GOFF(o20, 0); PG8_GOFF(o21, 1); } }
            const bool relax = (t == 0) && (ui > 0);
            PG8_LDB(B0, 0, 0); PG8_LDB(B1, 0, 1); PG8_SCHED; PG8_LDA(At, 0, 0); PG8_STAGE(PG8_SA(1, 1), a1, cOff[1]);
            PG8_WAIT_V8R(relax); PG8_WAIT_L(0); PG8_BAR; PG8_MMA(0, 0, At, B0); PG8_MMA(0, 1, At, B1); PG8_BAR; PG8_SCHED;
            PG8_LDA(At, 0, 1); PG8_STAGE(PG8_SB(0, 0), b2, voffB); PG8_STAGE(PG8_SB(0, 1), b2 + hstepB, voffB); PG8_STAGE(PG8_SA(0, 0), a2, o20);
            PG8_WAIT_V8R(relax); PG8_WAIT_L(0); PG8_BAR; PG8_MMA(1, 0, At, B0); PG8_MMA(1, 1, At, B1); PG8_BAR; PG8_SCHED;
            PG8_LDB(B0, 1, 0); PG8_LDB(B1, 1, 1); PG8_SCHED; PG8_LDA(At, 1, 0); PG8_STAGE(PG8_SA(0, 1), a2, o21);
            PG8_WAIT_V(8); PG8_WAIT_L(0); PG8_BAR; PG8_MMA(0, 0, At, B0); PG8_MMA(0, 1, At, B1); PG8_BAR; PG8_SCHED;
            PG8_LDA(At, 1, 1); PG8_STAGE(PG8_SB(1, 0), b3, voffB); PG8_STAGE(PG8_SB(1, 1), b3 + hstepB, voffB); PG8_STAGE(PG8_SA(1, 0), a3, o20);
            PG8_WAIT_V(8); PG8_WAIT_L(0); PG8_BAR; PG8_MMA(1, 0, At, B0); PG8_MMA(1, 1, At, B1); PG8_BAR; PG8_SCHED;
        }
        if (wr == 0) PG8_BAR;
        if constexpr (FP8) asm volatile("s_nop 15\n\ts_nop 15" ::: "memory");
        E(acc, cur, wr, wc, fr, fq);
        if (!has_next) break;
        if constexpr (has_pre<Epi>::value) E.template pre_apply<-1>(acc, lds, wid, fq);
        else {
#pragma unroll
        for (int a = 0; a < 2; ++a)
#pragma unroll
            for (int b = 0; b < 2; ++b)
#pragma unroll
                for (int m = 0; m < 4; ++m)
#pragma unroll
                    for (int n = 0; n < 2; ++n) acc[a][b][m][n] = (f32x4){0.f, 0.f, 0.f, 0.f}; }
        cur = nxt; cA = nA; cB = nB; ++ui;
#pragma unroll
        for (int h = 0; h < 2; ++h)
#pragma unroll
            for (int i = 0; i < 2; ++i) cOff[h][i] = cOff[h][i];
        if constexpr (Sched::GATHER) { PG8_GOFF(cOff[0], 0); PG8_GOFF(cOff[1], 1); }
        if (wr == 1) PG8_BAR;
    }
    PG8_WAIT_V(0);
    PG8_BAR;
#undef PG8_SA
#undef PG8_SB
#undef PG8_STAGE
#undef PG8_AOFF
#undef PG8_LDA
#undef PG8_LDB
#undef PG8_MMA
#undef PG8_WAIT_V
#undef PG8_WAIT_L
#undef PG8_BAR
#undef PG8_SCHED
}
typedef const f32x4 (&AccRef)[2][2][4][2];
typedef f32x4 (&AccMut)[2][2][4][2];

__device__ __forceinline__ u32x4 pack8(f32x4 v0, f32x4 v1) { u32x4 w; w.x = pk2(v0[0], v0[1]); w.y = pk2(v0[2], v0[3]); w.z = pk2(v1[0], v1[1]); w.w = pk2(v1[2], v1[3]); return w; }

#define ROW_OF(ai, m) (u.pm * BM + (ai) * HALF + wr * 64 + (m) * 16 + fr)
struct EpiInProj {
    static constexpr bool PERM = true; const float* rinv; unsigned char* ws;
    __device__ __forceinline__ void operator()(AccRef acc, const Unit& u, int wr, int wc, int fr, int fq) const {
        asm volatile("" : "+v"(fr), "+v"(fq));
        float rs[8];
#pragma unroll
        for (int q = 0; q < 8; ++q) rs[q] = rinv[ROW_OF(q >> 2, q & 3)];
#pragma unroll
        for (int ai = 0; ai < 2; ++ai)
#pragma unroll
            for (int m = 0; m < 4; ++m) { const int row = ROW_OF(ai, m); const float r1 = rs[ai * 4 + m];
#pragma unroll
                for (int bj = 0; bj < 2; ++bj) { const int col = bj * HALF + wc * 32 + 8 * fq; const u32x4 w = pack8(acc[ai][bj][m][0] * r1, acc[ai][bj][m][1] * r1);
                    bf16_t* dst;
                    if (u.pn == 0) dst = (bf16_t*)(ws + WS_UEXT) + ((size_t)((col >> 4) * NCHUNK + (row >> 6)) * KSSM + (row & 63) * 16 + (col & 15));
                    else dst = (bf16_t*)(ws + WS_UB + (size_t)(u.pn - 1) * 16 * MiB) + (size_t)row * 256 + col;
                    *(u32x4*)dst = w; } }
    }
};
struct EpiKv {
    static constexpr bool PERM = true; const float* rinv; bf16_t* out;
    __device__ __forceinline__ void operator()(AccRef acc, const Unit& u, int wr, int wc, int fr, int fq) const {
        asm volatile("" : "+v"(fr), "+v"(fq));
        float rs[8];
#pragma unroll
        for (int q = 0; q < 8; ++q) rs[q] = rinv[ROW_OF(q >> 2, q & 3)];
#pragma unroll
        for (int ai = 0; ai < 2; ++ai)
#pragma unroll
            for (int m = 0; m < 4; ++m) { const int row = ROW_OF(ai, m); const float r1 = rs[ai * 4 + m];
#pragma unroll
                for (int bj = 0; bj < 2; ++bj) { const int col = u.pn * BM + bj * HALF + wc * 32 + 8 * fq;
                    *(u32x4*)(out + ((size_t)u.grp * NMEM + row) * 512 + col) = pack8(acc[ai][bj][m][0] * r1, acc[ai][bj][m][1] * r1); } }
    }
};
struct EpiS {
    static constexpr bool PERM = false; float* out;
    __device__ __forceinline__ void operator()(AccRef acc, const Unit& u, int wr, int wc, int fr, int fq) const {
        asm volatile("" : "+v"(fr), "+v"(fq));
#pragma unroll
        for (int ai = 0; ai < 2; ++ai)
#pragma unroll
            for (int m = 0; m < 4; ++m) { const int row = ROW_OF(ai, m);
#pragma unroll
                for (int n = 0; n < 2; ++n) { const int col = wc * 32 + 16 * n + 4 * fq;
                    *(f32x4*)(out + ((size_t)u.grp * NCHUNK + row) * 128 + col) = acc[ai][0][m][n]; } }
    }
};
__device__ __forceinline__ float gelu_tanh(float y) {
    const float u2 = 1.5957691216057308f * (y + 0.044715f * y * y * y);
    return y * __builtin_amdgcn_rcpf(1.0f + __builtin_amdgcn_exp2f(-u2 * LOG2E));
}
struct EpiY {
    static constexpr bool PERM = true; bf16_t* z;
    __device__ __forceinline__ void operator()(AccRef acc, const Unit& u, int wr, int wc, int fr, int fq) const {
        asm volatile("" : "+v"(fr), "+v"(fq));
#pragma unroll
        for (int ai = 0; ai < 2; ++ai)
#pragma unroll
            for (int m = 0; m < 4; ++m) { const int row = ROW_OF(ai, m);
#pragma unroll
                for (int bj = 0; bj < 2; ++bj) { const int col = u.pn * BM + bj * HALF + wc * 32 + 8 * fq; f32x4 v0 = acc[ai][bj][m][0], v1 = acc[ai][bj][m][1];
#pragma unroll
                    for (int i = 0; i < 4; ++i) { v0[i] = gelu_tanh(v0[i]); v1[i] = gelu_tanh(v1[i]); }
                    *(u32x4*)(z + ((size_t)row * 64 + (col >> 4)) * 256 + u.grp * 16 + (col & 15)) = pack8(v0, v1); } }
    }
};
struct EpiGlu {
    static constexpr int PERM = 1; const bf16_t* z; const float* bias; bf16_t* merged; LAS float* part;
    __device__ __forceinline__ void operator()(AccRef acc, const Unit& u, int wr, int wc, int fr, int fq) const {
        asm volatile("" : "+v"(fr), "+v"(fq));
        f32x4 bb[2][2]; f32x4 o[2][4][2][2];
#pragma unroll
        for (int bj = 0; bj < 2; ++bj) { const int col = bj * HALF + wc * 32 + 8 * fq; bb[bj][0] = *(const f32x4*)(bias + col); bb[bj][1] = *(const f32x4*)(bias + col + 4); }
#pragma unroll
        for (int ai = 0; ai < 2; ++ai) {
            u32x4 zz[4][2];
#pragma unroll
            for (int m = 0; m < 4; ++m)
#pragma unroll
                for (int bj = 0; bj < 2; ++bj) zz[m][bj] = *(const u32x4*)(z + (size_t)ROW_OF(ai, m) * 256 + bj * HALF + wc * 32 + 8 * fq);
#pragma unroll
            for (int m = 0; m < 4; ++m) { float s = 0.f;
#pragma unroll
                for (int bj = 0; bj < 2; ++bj) { const u32x4 zq_ = zz[m][bj];
                    const f32x4 z0 = {bflo(zq_.x), bfhi(zq_.x), bflo(zq_.y), bfhi(zq_.y)}, z1 = {bflo(zq_.z), bfhi(zq_.z), bflo(zq_.w), bfhi(zq_.w)};
                    f32x4 v0 = acc[ai][bj][m][0] + bb[bj][0], v1 = acc[ai][bj][m][1] + bb[bj][1];
#pragma unroll
                    for (int i = 0; i < 4; ++i) { v0[i] = z0[i] * fast_sigmoid(v0[i]); v1[i] = z1[i] * fast_sigmoid(v1[i]); s += v0[i] * v0[i] + v1[i] * v1[i]; }
                    o[ai][m][bj][0] = v0; o[ai][m][bj][1] = v1; }
                s += __shfl_xor(s, 16); s += __shfl_xor(s, 32);
                if (fq == 0) part[(ai * HALF + wr * 64 + m * 16 + fr) * 4 + wc] = s; } }
        asm volatile("s_waitcnt lgkmcnt(0)" ::: "memory"); __builtin_amdgcn_s_barrier(); asm volatile("" ::: "memory");
#pragma unroll
        for (int ai = 0; ai < 2; ++ai)
#pragma unroll
            for (int m = 0; m < 4; ++m) { const f32x4 p4 = *(const LAS f32x4*)(part + (ai * HALF + wr * 64 + m * 16 + fr) * 4);
                const float rs = 1.0f / sqrtf(((p4[0] + p4[1]) + (p4[2] + p4[3])) * (1.0f / 256.0f) + EPS);
#pragma unroll
                for (int bj = 0; bj < 2; ++bj) *(u32x4*)(merged + (size_t)ROW_OF(ai, m) * DM + bj * HALF + wc * 32 + 8 * fq) = pack8(o[ai][m][bj][0] * rs, o[ai][m][bj][1] * rs); }
        asm volatile("s_waitcnt lgkmcnt(0)" ::: "memory"); __builtin_amdgcn_s_barrier(); asm volatile("" ::: "memory");
    }
};
struct EpiPool {
    static constexpr bool PERM = true; bf16_t* merged; float* ssq;
    __device__ __forceinline__ void operator()(AccRef acc, const Unit& u, int wr, int wc, int fr, int fq) const {
        asm volatile("" : "+v"(fr), "+v"(fq));
#pragma unroll
        for (int ai = 0; ai < 2; ++ai)
#pragma unroll
            for (int m = 0; m < 4; ++m) { const int row = ROW_OF(ai, m); float s = 0.f;
#pragma unroll
                for (int bj = 0; bj < 2; ++bj) { const int col = bj * HALF + wc * 32 + 8 * fq; const f32x4 v0 = acc[ai][bj][m][0], v1 = acc[ai][bj][m][1];
#pragma unroll
                    for (int i = 0; i < 4; ++i) s += v0[i] * v0[i] + v1[i] * v1[i];
                    *(u32x4*)(merged + (size_t)row * DM + 256 + col) = pack8(v0, v1); }
                s += __shfl_xor(s, 16); s += __shfl_xor(s, 32);
                if (fq == 0) ssq[(size_t)row * 16 + 4 + wc] = s; }
    }
};
struct EpiWout {
    static constexpr bool PERM = false; bf16_t* xb; float* ssq2;
    __device__ __forceinline__ void operator()(AccRef acc, const Unit& u, int wr, int wc, int fr, int fq) const {
        asm volatile("" : "+v"(fr), "+v"(fq));
#pragma unroll
        for (int ai = 0; ai < 2; ++ai) {
            u32x2 xo[4][2][2];
#pragma unroll
            for (int m = 0; m < 4; ++m)
#pragma unroll
                for (int bj = 0; bj < 2; ++bj)
#pragma unroll
                    for (int n = 0; n < 2; ++n) xo[m][bj][n] = *(const u32x2*)(xb + (size_t)ROW_OF(ai, m) * DM + u.pn * BM + bj * HALF + wc * 32 + 16 * n + 4 * fq);
#pragma unroll
            for (int m = 0; m < 4; ++m) { const int row = ROW_OF(ai, m); float s = 0.f;
#pragma unroll
                for (int bj = 0; bj < 2; ++bj)
#pragma unroll
                    for (int n = 0; n < 2; ++n) { const size_t off = (size_t)row * DM + u.pn * BM + bj * HALF + wc * 32 + 16 * n + 4 * fq; const u32x2 w0 = xo[m][bj][n];
                        const f32x4 xn = (f32x4){bflo(w0.x), bfhi(w0.x), bflo(w0.y), bfhi(w0.y)} + acc[ai][bj][m][n];
                        u32x2 w; w.x = pk2(xn[0], xn[1]); w.y = pk2(xn[2], xn[3]); *(u32x2*)(xb + off) = w;
                        s += (xn[0] * xn[0] + xn[1] * xn[1]) + (xn[2] * xn[2] + xn[3] * xn[3]); }
                s += __shfl_xor(s, 16); s += __shfl_xor(s, 32);
                if (fq == 0) ssq2[(size_t)row * 16 + u.pn * 4 + wc] = s; } }
    }
};
struct EpiRouter {
    static constexpr bool PERM = false; float* part;
    __device__ __forceinline__ void operator()(AccRef acc, const Unit& u, int wr, int wc, int fr, int fq) const {
        if (wc != 0) return;
        asm volatile("" : "+v"(fr), "+v"(fq));
#pragma unroll
        for (int ai = 0; ai < 2; ++ai)
#pragma unroll
            for (int m = 0; m < 4; ++m) { float* p = part + ((size_t)u.grp * NTOK + ROW_OF(ai, m)) * 32 + 4 * fq;
                *(f32x4*)p = acc[ai][0][m][0]; *(f32x4*)(p + 16) = acc[ai][0][m][1]; }
    }
};
struct EpiMoe1 {
    static constexpr bool PERM = true; const float* bg; const float* bu; unsigned char* h; int dry;
    struct Pre {};
    static constexpr int EMIN = 12;
    __device__ __forceinline__ void unit_top(LAS unsigned char*, const Unit&, int, int, int) const {}
    __device__ __forceinline__ void pre_load(LAS unsigned char* lds, const Unit& u, int wid, int wc, int fr, int fq) const { const size_t o = (size_t)u.grp * DM + u.pn * HALF + wc * 32 + 8 * fq;
        bias_dma(lds, (fr < 8 ? bg : bu - 8) + o + fr, wid); }
    template <int NY> __device__ __forceinline__ void pre_apply(AccMut acc, LAS unsigned char* lds, int wid, int fq) const { f32x4 b[4]; bias_read<NY>(lds, wid, fq, b);
#pragma unroll
        for (int ai = 0; ai < 2; ++ai)
#pragma unroll
            for (int m = 0; m < 4; ++m)
#pragma unroll
                for (int n = 0; n < 2; ++n) { acc[ai][0][m][n] = b[n] * WSCALE; acc[ai][1][m][n] = b[2 + n] * WSCALE; } }
    __device__ __forceinline__ void operator()(AccRef acc, const Unit& u, int wr, int wc, int fr, int fq) const {
        asm volatile("" : "+v"(fr), "+v"(fq));
        if (dry) { _Pragma("unroll") for (int ai = 0; ai < 2; ++ai) _Pragma("unroll") for (int bj = 0; bj < 2; ++bj) _Pragma("unroll") for (int m = 0; m < 4; ++m) _Pragma("unroll") for (int n = 0; n < 2; ++n) asm volatile("" :: "v"(acc[ai][bj][m][n])); asm volatile("s_waitcnt vmcnt(0)" ::: "memory"); return; }
        const int hid = u.pn * HALF + wc * 32 + 8 * fq;
        const float c1 = -1.702f * LOG2E * WUNSCALE;
#pragma unroll
        for (int ai = 0; ai < 2; ++ai)
#pragma unroll
            for (int m = 0; m < 4; ++m) { const int row = ROW_OF(ai, m); f32x2 hv[4];
#pragma unroll
                for (int q = 0; q < 4; ++q) { const f32x4 ag = acc[ai][0][m][q >> 1], au = acc[ai][1][m][q >> 1];
                    f32x2 G = (f32x2){ag[2 * (q & 1)], ag[2 * (q & 1) + 1]}, U = (f32x2){au[2 * (q & 1)], au[2 * (q & 1) + 1]};
                    G[0] = __builtin_amdgcn_fmed3f(G[0], -3.0e38f, 448.0f); G[1] = __builtin_amdgcn_fmed3f(G[1], -3.0e38f, 448.0f);
                    U[0] = __builtin_amdgcn_fmed3f(U[0], -448.0f, 448.0f); U[1] = __builtin_amdgcn_fmed3f(U[1], -448.0f, 448.0f);
                    const f32x2 t = G * c1 + 12.0f; const f32x2 d = (f32x2){__builtin_amdgcn_exp2f(t[0]), __builtin_amdgcn_exp2f(t[1])} + 4096.0f;
                    const f32x2 r = {__builtin_amdgcn_rcpf(d[0]), __builtin_amdgcn_rcpf(d[1])};
                    hv[q] = ((U + 64.0f) * G) * r; }
                u32x2 w; int w0 = 0, w1 = 0;
                w0 = __builtin_amdgcn_cvt_pk_fp8_f32(hv[0][0], hv[0][1], w0, false); w0 = __builtin_amdgcn_cvt_pk_fp8_f32(hv[1][0], hv[1][1], w0, true);
                w1 = __builtin_amdgcn_cvt_pk_fp8_f32(hv[2][0], hv[2][1], w1, false); w1 = __builtin_amdgcn_cvt_pk_fp8_f32(hv[3][0], hv[3][1], w1, true);
                w.x = (unsigned)w0; w.y = (unsigned)w1;
                *(u32x2*)(h + (size_t)row * DM + hid) = w; }
    }
};
struct EpiMoe2 {
    static constexpr int PERM = 2; const int* row_dst; const float* row_gate; const float* bd; unsigned char* slab; int dry;
    struct Pre {};
    static constexpr int EMIN = 5;
    __device__ __forceinline__ void unit_top(LAS unsigned char* lds, const Unit& u, int wid, int wr, int lane) const {
#pragma unroll
        for (int k = 0; k < 2; ++k) { const int row = u.pm * BM + 128 * k + 64 * wr + lane;
            __builtin_amdgcn_global_load_lds((const unsigned*)(row_dst + row), (LAS unsigned*)(lds + GOFF_OFF + wid * 1024 + k * 256), 4, 0, 0);
            __builtin_amdgcn_global_load_lds((const unsigned*)(row_gate + row), (LAS unsigned*)(lds + GOFF_OFF + wid * 1024 + (2 + k) * 256), 4, 0, 0); } }
    LAS unsigned char* ldsb;
    __device__ __forceinline__ void pre_load(LAS unsigned char* lds, const Unit& u, int wid, int wc, int fr, int fq) const { bias_dma(lds, bd + (size_t)u.grp * DM + u.pn * BM + wc * 64 + 16 * fq + fr, wid); }
    template <int NY> __device__ __forceinline__ void pre_apply(AccMut acc, LAS unsigned char* lds, int wid, int fq) const { f32x4 b[4]; bias_read<NY>(lds, wid, fq, b);
#pragma unroll
        for (int ai = 0; ai < 2; ++ai)
#pragma unroll
            for (int bj = 0; bj < 2; ++bj)
#pragma unroll
                for (int m = 0; m < 4; ++m)
#pragma unroll
                    for (int n = 0; n < 2; ++n) acc[ai][bj][m][n] = b[2 * bj + n] * WSCALE; }
    __device__ __forceinline__ void operator()(AccRef acc, const Unit& u, int wr, int wc, int fr, int fq) const {
        asm volatile("" : "+v"(fr), "+v"(fq));
        if (dry == 1) { _Pragma("unroll") for (int ai = 0; ai < 2; ++ai) _Pragma("unroll") for (int bj = 0; bj < 2; ++bj) _Pragma("unroll") for (int m = 0; m < 4; ++m) _Pragma("unroll") for (int n = 0; n < 2; ++n) asm volatile("" :: "v"(acc[ai][bj][m][n])); return; }
        const int c0 = u.pn * BM + wc * 64 + 16 * fq;
        int dsts[8]; float gts[8];
#pragma unroll
        for (int q = 0; q < 8; ++q) { const LAS unsigned char* sl = ldsb + GOFF_OFF + (wr * 4 + wc) * 1024 + (q >> 2) * 256 + (q & 3) * 64 + fr * 4;
            dsts[q] = *(const LAS int*)sl; gts[q] = *(const LAS float*)(sl + 512) * (SLAB_SCALE * WUNSCALE); }
#pragma unroll
        for (int ai = 0; ai < 2; ++ai)
#pragma unroll
            for (int m = 0; m < 4; ++m) { const int dst = dsts[ai * 4 + m]; const float g = gts[ai * 4 + m];
                if (dst >= 0) { u32x4 w;
#pragma unroll
                    for (int bj = 0; bj < 2; ++bj)
#pragma unroll
                        for (int n = 0; n < 2; ++n) { const f32x4 v = acc[ai][bj][m][n] * g; w[2 * bj + n] = pk4_fp8(v[0], v[1], v[2], v[3]); }
                    *(u32x4*)(slab + (size_t)dst * DM + c0) = w; } }
    }
};
#undef ROW_OF
}

namespace att {
constexpr int LDS_K = 0, LDS_V = 8192, LDS_CK = 16384, LDS_WS = 16640, LDS_OST = 18688, LDS_BYTES_ = LDS_OST + 8 * 4096;
__device__ __forceinline__ int crow(int r, int hi) { return (r & 3) + 8 * (r >> 2) + 4 * hi; }
typedef short v4i16_t __attribute__((ext_vector_type(4)));
__device__ __forceinline__ s16x4 vtr(const LAS unsigned char* p) { return __builtin_bit_cast(s16x4, __builtin_amdgcn_ds_read_tr16_b64_v4i16((LAS v4i16_t*)p)); }
typedef __bf16 bf16x2_t __attribute__((ext_vector_type(2)));
__device__ __forceinline__ unsigned cvtpk(float lo, float hi) { f32x2 v = {lo, hi}; bf16x2_t b = __builtin_convertvector(v, bf16x2_t); return __builtin_bit_cast(unsigned, b); }

__device__ __forceinline__ void unit(LAS unsigned char* shm, const bf16_t* Q, size_t qrow0, const bf16_t* K, const bf16_t* V, size_t kvrow0, int hcol, const float* ck, int NT, bool causal,
                                     bf16_t* obase, float* ssq) {
    int tid = threadIdx.x; asm volatile("" : "+v"(tid));
    const int lane = tid & 63, r32 = lane & 31, hi = lane >> 5; const int wid = __builtin_amdgcn_readfirstlane(tid >> 6);
    const bf16_t* Qw = Q + (qrow0 + wid * 32 + r32) * 256 + hcol;
    bf16x8 qr[4];
#pragma unroll
    for (int d0 = 0; d0 < 4; ++d0) qr[d0] = *(const bf16x8*)(Qw + d0 * 16 + hi * 8);
    float m_run = -INFINITY, l_run = 0.f; f32x16 o[2];
#pragma unroll
    for (int r = 0; r < 16; ++r) { o[0][r] = 0.f; o[1][r] = 0.f; }
    LAS float* wsf = (LAS float*)(shm + LDS_WS) + wid * 64;
    const LAS float* cks = (const LAS float*)(shm + LDS_CK);
    const LAS unsigned char* kb = shm + LDS_K + hi * 1024 + r32 * 16;
    const LAS unsigned char* vp = shm + LDS_V + ((lane >> 4) & 1) * 32 + (lane & 3) * 8 + (4 * hi + ((lane & 15) >> 2)) * 64;
    const int qrel = wid * 32 + r32;
    const bf16_t* ksrc = K + (kvrow0 + lane) * 256 + hcol + wid * 8;
    const bf16_t* vsrc = V + (kvrow0 + 16 * (wid & 3) + (lane >> 2)) * 256 + hcol + (wid >> 2) * 32 + (lane & 3) * 8;
    u32x4 kreg = *(const u32x4*)ksrc, vreg = *(const u32x4*)vsrc;
    for (int t = 0; t < NT; ++t) {
        __syncthreads();
        *(LAS u32x4*)(shm + LDS_K + wid * 1024 + lane * 16) = kreg;
        *(LAS u32x4*)(shm + LDS_V + wid * 1024 + lane * 16) = vreg;
        if (ck != nullptr && tid < 64) ((LAS float*)(shm + LDS_CK))[tid] = ck[t * 64 + tid];
        __syncthreads();
        if (t + 1 < NT) { kreg = *(const u32x4*)(ksrc + (size_t)(t + 1) * 64 * 256); vreg = *(const u32x4*)(vsrc + (size_t)(t + 1) * 64 * 256); }
        f32x16 p0, p1;
#pragma unroll
        for (int r = 0; r < 16; ++r) { p0[r] = 0.f; p1[r] = 0.f; }
#pragma unroll
        for (int d0 = 0; d0 < 4; ++d0) {
            const bf16x8 b0 = *(const LAS bf16x8*)(kb + d0 * 2048), b1 = *(const LAS bf16x8*)(kb + d0 * 2048 + 512);
            p0 = __builtin_amdgcn_mfma_f32_32x32x16_bf16(b0, qr[d0], p0, 0, 0, 0); p1 = __builtin_amdgcn_mfma_f32_32x32x16_bf16(b1, qr[d0], p1, 0, 0, 0); }
        if (ck != nullptr) {
#pragma unroll
            for (int r = 0; r < 16; ++r) { p0[r] -= cks[crow(r, hi)]; p1[r] -= cks[32 + crow(r, hi)]; } }
        if (causal && t >= NT - 4) { const int kb0 = 64 * (t - (NT - 4)) + 4 * hi;
#pragma unroll
            for (int r = 0; r < 16; ++r) { const int kv = kb0 + (r & 3) + 8 * (r >> 2); if (kv > qrel) p0[r] = -INFINITY; if (kv + 32 > qrel) p1[r] = -INFINITY; } }
        float rm = fmaxf(p0[0], p1[0]);
#pragma unroll
        for (int r = 1; r < 16; ++r) rm = fmaxf(rm, fmaxf(p0[r], p1[r]));
        rm = fmaxf(rm, __shfl_xor(rm, 32));
        const float mn = fmaxf(m_run, rm); const float alpha = __builtin_amdgcn_exp2f(m_run - mn); m_run = mn;
        float ls = 0.f;
#pragma unroll
        for (int r = 0; r < 16; ++r) { p0[r] = __builtin_amdgcn_exp2f(p0[r] - mn); p1[r] = __builtin_amdgcn_exp2f(p1[r] - mn); ls += p0[r] + p1[r]; }
        l_run = l_run * alpha + ls;
        if (hi == 0) wsf[r32] = alpha;
        LDS_WAIT();
#pragma unroll
        for (int r = 0; r < 16; ++r) { const float f = wsf[crow(r, hi)]; o[0][r] *= f; o[1][r] *= f; }
        bf16x8 pa[4];
        { u32x4 w;
          w.x = cvtpk(p0[0], p0[1]); w.y = cvtpk(p0[2], p0[3]); w.z = cvtpk(p0[4], p0[5]); w.w = cvtpk(p0[6], p0[7]); pa[0] = __builtin_bit_cast(bf16x8, w);
          w.x = cvtpk(p0[8], p0[9]); w.y = cvtpk(p0[10], p0[11]); w.z = cvtpk(p0[12], p0[13]); w.w = cvtpk(p0[14], p0[15]); pa[1] = __builtin_bit_cast(bf16x8, w);
          w.x = cvtpk(p1[0], p1[1]); w.y = cvtpk(p1[2], p1[3]); w.z = cvtpk(p1[4], p1[5]); w.w = cvtpk(p1[6], p1[7]); pa[2] = __builtin_bit_cast(bf16x8, w);
          w.x = cvtpk(p1[8], p1[9]); w.y = cvtpk(p1[10], p1[11]); w.z = cvtpk(p1[12], p1[13]); w.w = cvtpk(p1[14], p1[15]); pa[3] = __builtin_bit_cast(bf16x8, w); }
#pragma unroll
        for (int d0 = 0; d0 < 2; ++d0)
#pragma unroll
            for (int ks = 0; ks < 4; ++ks) { const s16x4 lo = vtr(vp + d0 * 4096 + ks * 1024), hh = vtr(vp + d0 * 4096 + ks * 1024 + 512);
                const bf16x8 vb = {lo[0], lo[1], lo[2], lo[3], hh[0], hh[1], hh[2], hh[3]};
                o[d0] = __builtin_amdgcn_mfma_f32_32x32x16_bf16(pa[ks], vb, o[d0], 0, 0, 0); }
    }
    l_run += __shfl_xor(l_run, 32);
    if (hi == 0) wsf[32 + r32] = l_run;
    LDS_WAIT();
    LAS bf16_t* stg = (LAS bf16_t*)(shm + LDS_OST) + wid * 2048;
#pragma unroll
    for (int r = 0; r < 16; ++r) { const int orow = crow(r, hi); const float rl = __builtin_amdgcn_rcpf(wsf[32 + orow]);
        stg[orow * 64 + r32] = (bf16_t)f2bf(o[0][r] * rl); stg[orow * 64 + 32 + r32] = (bf16_t)f2bf(o[1][r] * rl); }
    LDS_WAIT();
#pragma unroll
    for (int i = 0; i < 4; ++i) { const int row = i * 8 + (lane >> 3), ch = lane & 7; const u32x4 v = *(const LAS u32x4*)(stg + row * 64 + ch * 8);
        const size_t grow = qrow0 + wid * 32 + row;
        *(u32x4*)(obase + grow * DM + ch * 8) = v;
        float s = bflo(v.x) * bflo(v.x) + bfhi(v.x) * bfhi(v.x) + bflo(v.y) * bflo(v.y) + bfhi(v.y) * bfhi(v.y) + bflo(v.z) * bflo(v.z) + bfhi(v.z) * bfhi(v.z) + bflo(v.w) * bflo(v.w) + bfhi(v.w) * bfhi(v.w);
        s += __shfl_xor(s, 1); s += __shfl_xor(s, 2); s += __shfl_xor(s, 4);
        if (ch == 0) ssq[grow * 16] = s; }
    LDS_WAIT();
}
}

namespace attn_body {
using bf16=__hip_bfloat16;
using bf16x8=__attribute__((ext_vector_type(8)))short;
using s16x4=__attribute__((ext_vector_type(4)))short;
using f32x16=__attribute__((ext_vector_type(16)))float;
using u32x4=__attribute__((ext_vector_type(4)))unsigned;
constexpr int BATCH=8,NHEAD=4,SEQ=4096,D=64,DM=256,OPITCH=1024;
constexpr int NW=8,QBLK=32,QB=QBLK*NW,KVBLK=64,NQB=SEQ/QB;
constexpr int ATTN_PITCH=DM, ATTN_UNIT_ROWS=QB;
__device__ __forceinline__ int crow(int r,int hi){return (r&3)+8*(r>>2)+4*hi;}
#define SBAR() __builtin_amdgcn_sched_barrier(0)
__device__ __forceinline__ void cmask(f32x16&p0,f32x16&p1,int jb,int qrel,int hi){
  const float NEG=-INFINITY; int kb=64*jb+4*hi;
  #pragma unroll
  for(int r=0;r<16;++r){int kv=kb+(r&3)+8*(r>>2); if(kv>qrel)p0[r]=NEG; if(kv+32>qrel)p1[r]=NEG;}
}

constexpr int NSLOT=3, SLOTB=8192;
constexpr int LDS_K=0, LDS_V=NSLOT*SLOTB, LDS_WS=2*NSLOT*SLOTB, LDS_OST=LDS_WS+NW*64*4, LDS_CK=LDS_OST+NW*4096, LDS_BYTES=LDS_CK+SEQ*4;
constexpr float C2=0.125f*1.4426950408889634f;
__device__ __forceinline__ void glds16(const void*gsrc,unsigned lds_dst){unsigned keep;
  asm volatile("s_mov_b32 %0, m0\n\ts_mov_b32 m0, %2\n\ts_nop 0\n\tglobal_load_lds_dwordx4 %1, off\n\ts_mov_b32 m0, %0":"=&s"(keep):"v"(gsrc),"s"(lds_dst):"memory");}
__device__ __forceinline__ float max3f(float a,float b,float c){float r;asm("v_max3_f32 %0, %1, %2, %3":"=v"(r):"v"(a),"v"(b),"v"(c));return r;}
__device__ __forceinline__ float max2f(float a,float b){float r;asm("v_max_f32_e32 %0, %1, %2":"=v"(r):"v"(a),"v"(b));return r;}
__device__ __forceinline__ float fadd_s(float a,float b){float r;asm("v_add_f32_e32 %0, %1, %2":"=v"(r):"v"(a),"v"(b));return r;}
__device__ __forceinline__ float fsub_s(float a,float b){float r;asm("v_sub_f32_e32 %0, %1, %2":"=v"(r):"v"(a),"v"(b));return r;}
typedef float f32x2_t __attribute__((ext_vector_type(2))); typedef __bf16 bf16x2_t __attribute__((ext_vector_type(2)));
__device__ __forceinline__ unsigned cvtpk_s(float lo,float hi){f32x2_t v={lo,hi};bf16x2_t b=__builtin_convertvector(v,bf16x2_t);return __builtin_bit_cast(unsigned,b);}
#define WAIT_BAR(N) asm volatile("s_waitcnt vmcnt(" #N ") lgkmcnt(0)\n\ts_barrier":::"memory")

__device__ __forceinline__ void qkt(f32x16&p0,f32x16&p1,const char*Kslot,const bf16x8*qr,const f32x16&c0,const f32x16&c1,int r32,int hi){
  const char*kb=Kslot+hi*1024+r32*16;
  #pragma unroll
  for(int d0=0;d0<4;++d0){
    const bf16x8 b0=*reinterpret_cast<const bf16x8*>(kb+d0*2048);
    const bf16x8 b1=*reinterpret_cast<const bf16x8*>(kb+d0*2048+512);
    if(d0==0){p0=__builtin_amdgcn_mfma_f32_32x32x16_bf16(b0,qr[0],c0,0,0,0);p1=__builtin_amdgcn_mfma_f32_32x32x16_bf16(b1,qr[0],c1,0,0,0);}
    else{p0=__builtin_amdgcn_mfma_f32_32x32x16_bf16(b0,qr[d0],p0,0,0,0);p1=__builtin_amdgcn_mfma_f32_32x32x16_bf16(b1,qr[d0],p1,0,0,0);}}
}
typedef __attribute__((address_space(3))) const char* lds_cptr;
typedef __attribute__((address_space(3))) const float* lds_fptr;
typedef float f32x4v __attribute__((ext_vector_type(4)));
typedef short v4i16_t __attribute__((ext_vector_type(4)));
__device__ __forceinline__ void kload8(bf16x8*kf,lds_cptr kp){
  kf[0]=*(const __attribute__((address_space(3))) bf16x8*)(kp);      kf[1]=*(const __attribute__((address_space(3))) bf16x8*)(kp+512);
  kf[2]=*(const __attribute__((address_space(3))) bf16x8*)(kp+2048); kf[3]=*(const __attribute__((address_space(3))) bf16x8*)(kp+2560);
  kf[4]=*(const __attribute__((address_space(3))) bf16x8*)(kp+4096); kf[5]=*(const __attribute__((address_space(3))) bf16x8*)(kp+4608);
  kf[6]=*(const __attribute__((address_space(3))) bf16x8*)(kp+6144); kf[7]=*(const __attribute__((address_space(3))) bf16x8*)(kp+6656);
}
__device__ __forceinline__ void kload2(bf16x8*kf,lds_cptr kp,int j){ kf[2*j]=*(const __attribute__((address_space(3))) bf16x8*)(kp+j*2048); kf[2*j+1]=*(const __attribute__((address_space(3))) bf16x8*)(kp+j*2048+512); }
__device__ __forceinline__ s16x4 vtr(lds_cptr p){ return __builtin_bit_cast(s16x4,__builtin_amdgcn_ds_read_tr16_b64_v4i16((__attribute__((address_space(3))) v4i16_t*)p)); }
__device__ __forceinline__ float rowmax(const f32x16&p0,const f32x16&p1){
  float a=max3f(p0[0],p0[1],p1[0]),b=max3f(p0[2],p0[3],p1[1]);a=max3f(a,p1[2],p1[3]);
  #pragma unroll
  for(int r=4;r<16;r+=4){a=max3f(a,p0[r],p0[r+1]);b=max3f(b,p0[r+2],p0[r+3]);a=max3f(a,p1[r],p1[r+1]);b=max3f(b,p1[r+2],p1[r+3]);}
  const float m=max2f(a,b);
  auto rr=__builtin_amdgcn_permlane32_swap(__float_as_uint(m),__float_as_uint(m),false,false);
  return max2f(__uint_as_float(rr[0]),__uint_as_float(rr[1]));
}
__device__ __forceinline__ void pv(f32x16*o,int vb,bf16x8 pa0,bf16x8 pa1,bf16x8 pa2,bf16x8 pa3){
  #pragma unroll
  for(int d0=0;d0<2;++d0){s16x4 lo[4],hi[4];
    #pragma unroll
    for(int ks=0;ks<4;++ks){
      asm volatile("ds_read_b64_tr_b16 %0,%1 offset:%c2":"=&v"(lo[ks]):"v"(vb),"i"(d0*4096+ks*1024):"memory");
      asm volatile("ds_read_b64_tr_b16 %0,%1 offset:%c2":"=&v"(hi[ks]):"v"(vb),"i"(d0*4096+ks*1024+512):"memory");}
    asm volatile("s_waitcnt lgkmcnt(0)":::"memory");SBAR();
    #define PK(k) (bf16x8){lo[k][0],lo[k][1],lo[k][2],lo[k][3],hi[k][0],hi[k][1],hi[k][2],hi[k][3]}
    o[d0]=__builtin_amdgcn_mfma_f32_32x32x16_bf16(pa0,PK(0),o[d0],0,0,0);
    o[d0]=__builtin_amdgcn_mfma_f32_32x32x16_bf16(pa1,PK(1),o[d0],0,0,0);
    o[d0]=__builtin_amdgcn_mfma_f32_32x32x16_bf16(pa2,PK(2),o[d0],0,0,0);
    o[d0]=__builtin_amdgcn_mfma_f32_32x32x16_bf16(pa3,PK(3),o[d0],0,0,0);
    #undef PK
  }
}

#ifndef ATTN_STORE16
#define ATTN_STORE16(p,v) (*(u32x4*)(p)=(v))
#endif
template<int THRL> __device__ __forceinline__ void attn_unit(int b,int h,int qb,const bf16*Q,const bf16*__restrict__ K,const bf16*__restrict__ V,bf16*O,const float*ckg,float*ssq,char*shm,const float skipthr){
  int tid=threadIdx.x; asm volatile("":"+v"(tid)); const int lane=tid&63,r32=lane&31,hi=lane>>5; const int wid=__builtin_amdgcn_readfirstlane(tid>>6);
  const long rowbase=(long)b*SEQ; const int q0=qb*QB;
  { float*ckl=(float*)(shm+LDS_CK); const int nk_=q0+QB; f32x4v c0_={0.f,0.f,0.f,0.f},c1_={0.f,0.f,0.f,0.f}; if(4*tid<nk_)c0_=*(const f32x4v*)(ckg+4*tid); if(2048+4*tid<nk_)c1_=*(const f32x4v*)(ckg+2048+4*tid);
    if(4*tid<nk_)*(f32x4v*)(ckl+4*tid)=c0_; if(2048+4*tid<nk_)*(f32x4v*)(ckl+2048+4*tid)=c1_; }
  int t0=0;
  { const int kmax=((q0+QB)/KVBLK-4)/2; const float cq=ckg[q0]; int lo=0,hi_=kmax;
    while(lo<hi_){ const int mid=(lo+hi_+1)>>1; if(ckg[128*mid-1]-cq>=skipthr)lo=mid; else hi_=mid-1; }
    t0=__builtin_amdgcn_readfirstlane(2*lo); }
  const lds_fptr ckp0=(lds_fptr)(shm)+LDS_CK/4+4*hi+t0*KVBLK;
  const bf16*Qw=Q+(rowbase+q0+wid*QBLK)*DM+h*D;
  const bf16*Kh=K+(rowbase+(long)t0*KVBLK)*DM+h*D,*Vh=V+(rowbase+(long)t0*KVBLK)*DM+h*D;
  const unsigned lds0=(unsigned)(uintptr_t)shm;
  float*wsf=(float*)(shm+LDS_WS)+wid*64;
  const bf16*ksrc=Kh+(long)lane*DM+wid*8;
  const bf16*vsrc=Vh+(long)(16*(wid&3)+(lane>>2))*DM+(wid>>2)*32+(lane&3)*8;
  const unsigned kdst=lds0+LDS_K+wid*1024, vdst=lds0+LDS_V+wid*1024;
  #define DMA_K(t,slot) glds16(ksrc+(long)(t)*KVBLK*DM,(unsigned)__builtin_amdgcn_readfirstlane(kdst+(slot)))
  #define DMA_V(t,slot) glds16(vsrc+(long)(t)*KVBLK*DM,(unsigned)__builtin_amdgcn_readfirstlane(vdst+(slot)))
  const int vb0=(int)(lds0+LDS_V)+((lane>>4)&1)*32+(lane&3)*8+(4*hi+((lane&15)>>2))*64;
  const char*Kbase=shm+LDS_K; bf16x8 kf[8];
  const lds_cptr shm3=(lds_cptr)shm; const lds_cptr kp0=shm3+LDS_K+hi*1024+r32*16; const lds_cptr vp0=shm3+LDS_V+((lane>>4)&1)*32+(lane&3)*8+(4*hi+((lane&15)>>2))*64;
  const int NT=(q0+QB)/KVBLK-t0;
  DMA_K(0,0);DMA_V(0,0);DMA_K(1,SLOTB);
  bf16x8 qr[4];
  #pragma unroll
  for(int d0=0;d0<4;++d0)qr[d0]=*reinterpret_cast<const bf16x8*>(&Qw[(long)r32*DM+d0*16+hi*8]);
  float mhat=0.f,l_reg=0.f,nmh=0.f;f32x16 o[2];o[0]=f32x16{};o[1]=f32x16{};
  #define CINIT(C0,C1,t) do{ const lds_fptr cp_=ckp0+(t)*KVBLK; _Pragma("unroll") for(int g_=0;g_<4;++g_){ const f32x4v a_=*(const __attribute__((address_space(3))) f32x4v*)(cp_+8*g_), b_=*(const __attribute__((address_space(3))) f32x4v*)(cp_+32+8*g_); \
      _Pragma("unroll") for(int i_=0;i_<4;++i_){C0[4*g_+i_]=nmh-a_[i_];C1[4*g_+i_]=nmh-b_[i_];} } }while(0)
  const int qrel=wid*QBLK+r32;
  #define CMASK(P0,P1,t) do{int jb_=(t)-(NT-4); if(jb_>=0)cmask(P0,P1,jb_,qrel,hi);}while(0)
  bool resc=false;
  #define START(P0,P1) do{ const float rm=rowmax(P0,P1); resc=false; \
    { const float dl=rm; mhat=fadd_s(mhat,dl); \
      _Pragma("unroll") for(int r=0;r<16;++r){P0[r]=fsub_s(P0[r],dl);P1[r]=fsub_s(P1[r],dl);} \
      nmh=-mhat; } \
    _Pragma("unroll") for(int r=0;r<16;++r)P0[r]=__builtin_amdgcn_exp2f(P0[r]); }while(0)
  #define RESC() do{ if(resc){ asm volatile("s_waitcnt lgkmcnt(0)":::"memory"); \
      _Pragma("unroll") for(int d_=0;d_<2;++d_) _Pragma("unroll") for(int r=0;r<16;++r)o[d_][r]*=wsf[crow(r,hi)]; } }while(0)
  f32x16 pA0,pA1,pB0,pB1;
  int sl_prev=0,sl_cur=0,sl_next=SLOTB;
  #define ROT() do{sl_prev=sl_cur;sl_cur=sl_next;sl_next=(sl_next==(NSLOT-1)*SLOTB)?0:sl_next+SLOTB;}while(0)
  DMA_K(2,2*SLOTB);
  WAIT_BAR(3);
  { f32x16 ci0,ci1; CINIT(ci0,ci1,0); qkt(pA0,pA1,Kbase,qr,ci0,ci1,r32,hi); } asm volatile("s_nop 15\n\ts_nop 7":"+v"(pA0),"+v"(pA1));CMASK(pA0,pA1,0);
  START(pA0,pA1);
  _Pragma("unroll") for(int r=0;r<16;++r)pA1[r]=__builtin_amdgcn_exp2f(pA1[r]);
  WAIT_BAR(0);
  DMA_K(3,0);DMA_V(1,SLOTB);
  ROT();
  kload8(kf,kp0+sl_cur);
  WAIT_BAR(2);
  s16x4 vlo[8],vhi[8]; u32x4 pw0,pw1,pw2,pw3;
  #define PKW(P,B) cvtpk_s(P[B],P[B+1])
  #define PAF(k) __builtin_bit_cast(bf16x8,pw##k)
  #define VFR(i) (bf16x8){vlo[i][0],vlo[i][1],vlo[i][2],vlo[i][3],vhi[i][0],vhi[i][1],vhi[i][2],vhi[i][3]}
  #define PIN(x) asm volatile("":"+v"(x))
  #define MX3(a,b,c) __builtin_fmaxf(__builtin_fmaxf((a),(b)),(c))
  #define GAPA(MF,A0,A1,A2,A3,W0,W1,PW) do{ MF; sacc+=A0; sacc+=A1; sacc+=A2; sacc+=A3; PIN(sacc); W0; W1; PIN(PW); SBAR(); }while(0)
  #define EX(v) __builtin_amdgcn_exp2f(v)
  #define GAPB(MF,X,B) do{ MF; X[B]=EX(X[B]); X[B+1]=EX(X[B+1]); X[B+2]=EX(X[B+2]); X[B+3]=EX(X[B+3]); PIN(X); SBAR(); }while(0)
  #define VRD(i) do{ vlo[i]=vtr(vp_+(((i)>>2)*4096+((i)&3)*1024)); vhi[i]=vtr(vp_+(((i)>>2)*4096+((i)&3)*1024+512)); }while(0)
  #define KRD(G,j) do{ if(G){ kload2(kf,kp0+sl_next,j); SBAR(); } }while(0)
  #define STEP(C0,C1,P0,P1,t,GK,GV,GL) do{ SBAR(); \
    CINIT(C0,C1,t); SBAR(); \
    const lds_cptr vp_=vp0+sl_prev; \
    VRD(0); SBAR(); float sacc=(P0[0]+P0[1]); \
    GAPA(C0=__builtin_amdgcn_mfma_f32_32x32x16_bf16(kf[0],qr[0],C0,0,0,0), P0[2],P0[3],P0[4],P0[5],     pw0[0]=PKW(P0,0), pw0[1]=PKW(P0,2), pw0); \
    VRD(4); SBAR(); GAPA(C1=__builtin_amdgcn_mfma_f32_32x32x16_bf16(kf[1],qr[0],C1,0,0,0), P0[6],P0[7],P0[8],P0[9],     pw0[2]=PKW(P0,4), pw0[3]=PKW(P0,6), pw0); \
    VRD(1); SBAR(); GAPA(C0=__builtin_amdgcn_mfma_f32_32x32x16_bf16(kf[2],qr[1],C0,0,0,0),   P0[10],P0[11],P0[12],P0[13], pw1[0]=PKW(P0,8), pw1[1]=PKW(P0,10), pw1); \
    VRD(5); SBAR(); GAPA(C1=__builtin_amdgcn_mfma_f32_32x32x16_bf16(kf[3],qr[1],C1,0,0,0),   P0[14],P0[15],P1[0],P1[1],   pw1[2]=PKW(P0,12),pw1[3]=PKW(P0,14), pw1); \
    VRD(2); SBAR(); GAPA(C0=__builtin_amdgcn_mfma_f32_32x32x16_bf16(kf[4],qr[2],C0,0,0,0),   P1[2],P1[3],P1[4],P1[5],     pw2[0]=PKW(P1,0), pw2[1]=PKW(P1,2), pw2); \
    VRD(6); SBAR(); GAPA(C1=__builtin_amdgcn_mfma_f32_32x32x16_bf16(kf[5],qr[2],C1,0,0,0),   P1[6],P1[7],P1[8],P1[9],     pw2[2]=PKW(P1,4), pw2[3]=PKW(P1,6), pw2); \
    VRD(3); SBAR(); GAPA(C0=__builtin_amdgcn_mfma_f32_32x32x16_bf16(kf[6],qr[3],C0,0,0,0),   P1[10],P1[11],P1[12],P1[13], pw3[0]=PKW(P1,8), pw3[1]=PKW(P1,10), pw3); \
    VRD(7); SBAR(); GAPA(C1=__builtin_amdgcn_mfma_f32_32x32x16_bf16(kf[7],qr[3],C1,0,0,0),   P1[14],P1[15],0.f,0.f,       pw3[2]=PKW(P1,12),pw3[3]=PKW(P1,14), pw3); \
    l_reg+=sacc; \
    if(GK){DMA_K((t)+3,sl_cur);} if(GV){DMA_V((t)+1,sl_next);} \
    CMASK(C0,C1,t); \
    { float a=MX3(C0[0],C0[1],C1[0]),b=MX3(C0[2],C0[3],C1[1]); a=MX3(a,C1[2],C1[3]); \
      _Pragma("unroll") for(int r=4;r<16;r+=4){a=MX3(a,C0[r],C0[r+1]);b=MX3(b,C0[r+2],C0[r+3]);a=MX3(a,C1[r],C1[r+1]);b=MX3(b,C1[r+2],C1[r+3]);} \
      float rm=__builtin_fmaxf(a,b); { auto rr=__builtin_amdgcn_permlane32_swap(__float_as_uint(rm),__float_as_uint(rm),false,false); rm=__builtin_fmaxf(__uint_as_float(rr[0]),__uint_as_float(rr[1])); } \
      resc=false; \
      if(__builtin_expect(__any(rm>(float)THRL),0)){ const float dl=__builtin_fmaxf(rm,0.f); mhat+=dl; \
        _Pragma("unroll") for(int r=0;r<16;++r){C0[r]-=dl;C1[r]-=dl;} \
        nmh=-mhat; \
        const float f=__builtin_amdgcn_exp2f(-dl); l_reg*=f; if(hi==0)wsf[r32]=f; resc=true; } } \
    SBAR(); \
    GAPB(o[0]=__builtin_amdgcn_mfma_f32_32x32x16_bf16(PAF(0),VFR(0),o[0],0,0,0), C0,0); \
    GAPB(o[1]=__builtin_amdgcn_mfma_f32_32x32x16_bf16(PAF(0),VFR(4),o[1],0,0,0), C0,4); \
    KRD(GL,0); GAPB(o[0]=__builtin_amdgcn_mfma_f32_32x32x16_bf16(PAF(1),VFR(1),o[0],0,0,0), C0,8); \
    KRD(GL,1); GAPB(o[1]=__builtin_amdgcn_mfma_f32_32x32x16_bf16(PAF(1),VFR(5),o[1],0,0,0), C0,12); \
    KRD(GL,2); GAPB(o[0]=__builtin_amdgcn_mfma_f32_32x32x16_bf16(PAF(2),VFR(2),o[0],0,0,0), C1,0); \
    KRD(GL,3); GAPB(o[1]=__builtin_amdgcn_mfma_f32_32x32x16_bf16(PAF(2),VFR(6),o[1],0,0,0), C1,4); \
    GAPB(o[0]=__builtin_amdgcn_mfma_f32_32x32x16_bf16(PAF(3),VFR(3),o[0],0,0,0), C1,8); \
    GAPB(o[1]=__builtin_amdgcn_mfma_f32_32x32x16_bf16(PAF(3),VFR(7),o[1],0,0,0), C1,12); \
    }while(0)
  int t=1;
  #undef CMASK
  #define CMASK(P0,P1,t) do{}while(0)
  for(;t+5<NT;t+=2){
    STEP(pB0,pB1,pA0,pA1,t,true,true,true);     WAIT_BAR(2); RESC(); ROT();
    STEP(pA0,pA1,pB0,pB1,t+1,true,true,true);   WAIT_BAR(2); RESC(); ROT();
  }
  #undef CMASK
  #define CMASK(P0,P1,t) do{int jb_=(t)-(NT-4); if(jb_>=0)cmask(P0,P1,jb_,qrel,hi);}while(0)
  #define ENDW(tt) do{ if((tt)+3<NT){WAIT_BAR(2);} else if((tt)+2<NT){WAIT_BAR(1);} else {WAIT_BAR(0);} }while(0)
  for(;t+1<NT;t+=2){
    STEP(pB0,pB1,pA0,pA1,t,(t+3<NT),(t+1<NT),(t+1<NT));       ENDW(t);   RESC(); ROT();
    STEP(pA0,pA1,pB0,pB1,t+1,(t+4<NT),(t+2<NT),(t+2<NT));     ENDW(t+1); RESC(); ROT();
  }
  STEP(pB0,pB1,pA0,pA1,NT-1,false,false,false); RESC();
  { float sacc=pB0[0]+pB0[1]; _Pragma("unroll") for(int r=2;r<16;++r)sacc+=pB0[r]; _Pragma("unroll") for(int r=0;r<16;++r)sacc+=pB1[r]; l_reg+=sacc;
    pw0=(u32x4){PKW(pB0,0),PKW(pB0,2),PKW(pB0,4),PKW(pB0,6)};pw1=(u32x4){PKW(pB0,8),PKW(pB0,10),PKW(pB0,12),PKW(pB0,14)};pw2=(u32x4){PKW(pB1,0),PKW(pB1,2),PKW(pB1,4),PKW(pB1,6)};pw3=(u32x4){PKW(pB1,8),PKW(pB1,10),PKW(pB1,12),PKW(pB1,14)};
    SBAR(); pv(o,vb0+sl_cur,PAF(0),PAF(1),PAF(2),PAF(3)); }
  #undef PKW
  #undef PAF
  #undef VFR
  #undef PIN
  #undef MX3
  #undef GAPA
  #undef GAPB
  #undef EX
  #undef VRD
  #undef KRD
  #undef STEP
  #undef ENDW
  {auto rr=__builtin_amdgcn_permlane32_swap(__float_as_uint(l_reg),__float_as_uint(l_reg),false,false);l_reg=__uint_as_float(rr[0])+__uint_as_float(rr[1]);}
  if(hi==0)wsf[32+r32]=l_reg;asm volatile("s_waitcnt lgkmcnt(0)":::"memory");
  float rli[16];
  #pragma unroll
  for(int r=0;r<16;++r)rli[r]=__builtin_amdgcn_rcpf(wsf[32+crow(r,hi)]);
  bf16*Ow=O+(rowbase+q0+wid*QBLK)*OPITCH; float*sq=ssq+(rowbase+q0+wid*QBLK)*16;
  { bf16*stg=(bf16*)(shm+LDS_OST)+wid*2048;
    #pragma unroll
    for(int r=0;r<16;++r){const int orow=crow(r,hi);
      #pragma unroll
      for(int d0=0;d0<2;++d0)stg[orow*64+d0*32+r32]=__float2bfloat16(o[d0][r]*rli[r]);}
    asm volatile("s_waitcnt lgkmcnt(0)":::"memory");
    #pragma unroll
    for(int i=0;i<4;++i){const int row=i*8+(lane>>3),ch=lane&7; const u32x4 v=*(const u32x4*)(stg+row*64+ch*8); ATTN_STORE16(Ow+(long)row*OPITCH+ch*8,v);
      float s_=0.f; _Pragma("unroll") for(int e_=0;e_<4;++e_){const float lo_=__builtin_bit_cast(float,v[e_]<<16),hi_=__builtin_bit_cast(float,v[e_]&0xffff0000u); s_+=lo_*lo_+hi_*hi_;}
      s_+=__shfl_xor(s_,1);s_+=__shfl_xor(s_,2);s_+=__shfl_xor(s_,4); if(ch==0)sq[row*16]=s_; } }
  asm volatile("s_waitcnt lgkmcnt(0)\n\ts_barrier":::"memory");
  #undef DMA_K
  #undef DMA_V
  #undef CMASK
  #undef START
  #undef RESC
  #undef ROT
  #undef CINIT
}
constexpr int ATTN_LDS_BYTES=LDS_BYTES;
#undef SBAR
#undef WAIT_BAR
}

__device__ __forceinline__ void tr_item64(const float* W, int ldw, int k0, int ns0, bf16_t* WT, int ldt, int drow0, const float* ksc, LAS float* scr, int lane) {
    const int c4 = (lane & 15) * 4, r0 = lane >> 4;
#pragma unroll 4
    for (int i = 0; i < 16; ++i) { const int kk = 4 * i + r0; f32x4 v = *(const f32x4*)(W + (size_t)(k0 + kk) * ldw + ns0 + c4);
        if (ksc) { const float s = ksc[k0 + kk]; v = v * s; }
        LAS float* d = scr + kk * 65 + c4; d[0] = v[0]; d[1] = v[1]; d[2] = v[2]; d[3] = v[3]; }
    LDS_WAIT(); asm volatile("" ::: "memory");
    const int c = lane & 7;
#pragma unroll
    for (int j = 0; j < 8; ++j) { const int n = (lane >> 3) + 8 * j; const LAS float* s = scr + (8 * c) * 65 + n;
        u32x4 o; o.x = pk2(s[0], s[65]); o.y = pk2(s[130], s[195]); o.z = pk2(s[260], s[325]); o.w = pk2(s[390], s[455]);
        *(u32x4*)(WT + (size_t)(drow0 + n) * ldt + k0 + 8 * c) = o; }
    LDS_WAIT(); asm volatile("" ::: "memory");
}
struct TrItem { const float* W; unsigned char* WT; const float* ksc; int k0, ns0, drow0; };
__device__ __forceinline__ void tr8_issue(const TrItem& t, f32x4 (&vv)[16], int lane) {
    const int c4 = (lane & 15) * 4, r0 = lane >> 4;
#pragma unroll
    for (int i = 0; i < 16; ++i) { const int kk = 4 * i + r0; vv[i] = __builtin_nontemporal_load((const f32x4*)(t.W + (size_t)(t.k0 + kk) * DM + t.ns0 + c4)); }
}
__device__ __forceinline__ void tr8_finish(const TrItem& t, const f32x4 (&vv)[16], LAS float* scr, int lane) {
    const int c4 = (lane & 15) * 4, r0 = lane >> 4;
#pragma unroll
    for (int i = 0; i < 16; ++i) { const int kk = 4 * i + r0; const float sc = t.ksc ? t.ksc[t.k0 + kk] * WSCALE : WSCALE; const f32x4 v = vv[i] * sc;
        LAS float* d = scr + kk * 65 + c4; d[0] = v[0]; d[1] = v[1]; d[2] = v[2]; d[3] = v[3]; }
    LDS_WAIT(); asm volatile("" ::: "memory");
    const int c = lane & 7;
#pragma unroll
    for (int j = 0; j < 8; ++j) { const int n = (lane >> 3) + 8 * j; const LAS float* s = scr + (8 * c) * 65 + n;
        u32x2 o; o.x = pk4_fp8(s[0], s[65], s[130], s[195]); o.y = pk4_fp8(s[260], s[325], s[390], s[455]);
        *(u32x2*)(t.WT + (size_t)(t.drow0 + n) * DM + t.k0 + 8 * c) = o; }
    LDS_WAIT(); asm volatile("" ::: "memory");
}
constexpr int CNIT = 3 * NE * 256;
#ifndef CONV_P0N
#define CONV_P0N CNIT
#endif
#ifndef MIXPREP_HOST
#define MIXPREP_HOST 1
#endif
#ifndef MIX_KC
#define MIX_KC 0
#endif
#ifndef CONV_P0K
#define CONV_P0K 12288
#endif
#ifndef CONV_P0S
#define CONV_P0S 18432
#endif
constexpr int CQ_WORD = 8448;
__device__ __forceinline__ void ce_item(const Args& a, int zq, int g, TrItem& t) {
    const int l = g >= CNIT ? 1 : 0, it = g - l * CNIT;
    const int mat = it / (NE * 256), r = it % (NE * 256), e = r >> 8, nb = (r >> 4) & 15, kb = r & 15;
    t.k0 = 64 * kb; t.ns0 = 64 * nb;
    const size_t wo = ((size_t)l * NE + e) * DM * DM;
    unsigned char* wgu_t = (a.ws + zq) + WS_WGU + ((size_t)l * NE + e) * 2048 * DM;
    if (mat == 0) { t.W = a.in[I_EWG + zq] + wo; t.WT = wgu_t; t.ksc = a.in[I_FFNG + zq] + l * DM; t.drow0 = (nb >> 1) * 256 + (nb & 1) * 64; }
    else if (mat == 1) { t.W = a.in[I_EWU + zq] + wo; t.WT = wgu_t; t.ksc = a.in[I_FFNG + zq] + l * DM; t.drow0 = (nb >> 1) * 256 + 128 + (nb & 1) * 64; }
    else { t.W = a.in[I_EWD + zq] + wo; t.WT = (a.ws + zq) + WS_WD + wo; t.ksc = nullptr; t.drow0 = 64 * nb; }
}
__device__ __forceinline__ void conv_static(const Args& a, int zq, const int s0, const int e0, int w0, int nw, LAS float* scr, int lane) {
    f32x4 va[16], vb[16]; TrItem ta, tb;
    int it = s0 + w0;
    if (it < e0) { ce_item(a, zq, it, ta); tr8_issue(ta, va, lane); }
    while (it < e0) {
        int nx = it + nw; if (nx < e0) { ce_item(a, zq, nx, tb); tr8_issue(tb, vb, lane); }
        tr8_finish(ta, va, scr, lane); it = nx; if (it >= e0) break;
        nx = it + nw; if (nx < e0) { ce_item(a, zq, nx, ta); tr8_issue(ta, va, lane); }
        tr8_finish(tb, vb, scr, lane); it = nx;
    }
}
__device__ __forceinline__ void conv_pull(const Args& a, int zq, const int limit, const unsigned stopthr, const bool may_claim, LAS unsigned char* lds, int tid, int wave, int lane) {
    unsigned long long* q64 = (unsigned long long*)((unsigned*)(a.ws + zq + WS_CTL) + CQ_WORD);
    volatile LAS int* cw = (volatile LAS int*)(lds + MISC_OFF + 128);
    LAS float* scr = (LAS float*)(lds + wave * 16640);
    f32x4 va[16], vb[16]; TrItem ta, tb; bool have_b = false;
    unsigned long long pre = 0ull; int have_pre = 0;
    for (int rnd = 0;; ++rnd) {
        if (tid == 0) { int p = cw[0] - 1, go = 1;
            if (p >= 0) { if (stopthr && __hip_atomic_load((unsigned*)q64 + 1, __ATOMIC_RELAXED, __HIP_MEMORY_SCOPE_AGENT) >= stopthr) go = 0; }
            else if (!may_claim) { go = 0; p = -1; }
            else { const unsigned long long v = have_pre ? pre : __hip_atomic_fetch_add(q64, 1ull, __ATOMIC_RELAXED, __HIP_MEMORY_SCOPE_AGENT); have_pre = 0;
                const unsigned lo = (unsigned)v, hi = (unsigned)(v >> 32);
                p = CONV_P0N + 16 * (int)(lo < (unsigned)CNIT ? lo : (unsigned)CNIT);
                if (p >= 2 * CNIT) { go = 0; p = -1; }
                else if (stopthr && hi >= stopthr) go = 0; }
            if (go && p >= limit) go = 0;
            cw[0] = go ? 0 : p + 1;
            cw[1 + (rnd & 1)] = go ? p : -1;
            if (go && may_claim) { pre = __hip_atomic_fetch_add(q64, 1ull, __ATOMIC_RELAXED, __HIP_MEMORY_SCOPE_AGENT); have_pre = 1; } }
        __syncthreads();
        const int p = cw[1 + (rnd & 1)];
        if (p < 0) break;
        ce_item(a, zq, p + 2 * wave, ta); tr8_issue(ta, va, lane);
        if (have_b) tr8_finish(tb, vb, scr, lane);
        ce_item(a, zq, p + 2 * wave + 1, tb); tr8_issue(tb, vb, lane); have_b = true;
        tr8_finish(ta, va, scr, lane);
    }
    if (have_b) tr8_finish(tb, vb, scr, lane);
}
#define HOST_NOTE() do { if (tid == 0) (void)__hip_atomic_fetch_add((unsigned long long*)((unsigned*)(ws + WS_CTL) + CQ_WORD), 1ull << 32, __ATOMIC_RELAXED, __HIP_MEMORY_SCOPE_AGENT); } while (0)
#define HOST_THR(hidx, n_long) ((unsigned)(G * (hidx) + (G - (n_long)) + 1))
__device__ __forceinline__ void apow(float lr, float li, float dt, int k, float& re, float& im) {
    const float mag = __builtin_amdgcn_exp2f((float)k * lr * dt * LOG2E);
    const double rev = (double)k * (double)li * (double)dt * 0.15915494309189535;
    const float fr = (float)(rev - __builtin_rint(rev));
    re = mag * __builtin_amdgcn_cosf(fr); im = mag * __builtin_amdgcn_sinf(fr);
}
__device__ __forceinline__ void ssm_setup(const Args& a, int zq, int lg, LAS float* Ar, LAS float* Ai, LAS float* bbr, LAS float* bbi, LAS float* cr, LAS float* ci, const int tid) {
    const float* lre = a.in[I_LRE + zq] + lg * 64; const float* lim = a.in[I_LIM + zq] + lg * 64; const float dt = expf(a.in[I_LDT + zq][lg]);
    for (int idx = tid; idx < 65 * 64; idx += NTHR) { const int k = idx >> 6, p = idx & 63; float re, im; apow(lre[p], lim[p], dt, k, re, im); Ar[idx] = re; Ai[idx] = im; }
    for (int idx = tid; idx < 1024; idx += NTHR) { const int p = idx >> 4;
        const float lr = lre[p], li = lim[p]; float are, aim; apow(lr, li, dt, 1, are, aim);
        const float den = lr * lr + li * li, nre = are - 1.0f, nim = aim, kre = (nre * lr + nim * li) / den, kim = (nim * lr - nre * li) / den;
        const float br = a.in[I_BRE + zq][(size_t)lg * 1024 + idx], bi = a.in[I_BIM + zq][(size_t)lg * 1024 + idx];
        bbr[idx] = kre * br - kim * bi; bbi[idx] = kre * bi + kim * br;
        cr[idx] = a.in[I_CRE + zq][(size_t)lg * 1024 + idx]; ci[idx] = a.in[I_CIM + zq][(size_t)lg * 1024 + idx]; }
    __syncthreads();
}
__device__ __forceinline__ void ssm_stage1(const Args& a, int zq, int unit, LAS unsigned char* lds, const int tid) {
    const int lg = unit >> 3, ks = unit & 7;
    LAS float* Ar = (LAS float*)lds; LAS float* Ai = Ar + 65 * 64; LAS float* bbr = Ai + 65 * 64; LAS float* bbi = bbr + 1024; LAS float* cr = bbi + 1024; LAS float* ci = cr + 1024;
    ssm_setup(a, zq, lg, Ar, Ai, bbr, bbi, cr, ci, tid);
    const float* dsk = a.in[I_SD + zq] + lg * 16; float* mt = (float*)((a.ws + zq) + WS_MTAB) + (size_t)lg * 64 * 256;
    for (int idx = tid; idx < 8 * 256; idx += NTHR) { const int k = 8 * ks + (idx >> 8), c1 = (idx >> 4) & 15, c0 = idx & 15; float s = 0.f;
        for (int p = 0; p < 64; ++p) { const float xr = cr[c1 * 64 + p], xi = ci[c1 * 64 + p], ar = Ar[k * 64 + p], ai = Ai[k * 64 + p];
            const float wr_ = xr * ar - xi * ai, wi_ = xr * ai + xi * ar; s += wr_ * bbr[p * 16 + c0] - wi_ * bbi[p * 16 + c0]; }
        if (k == 0 && c1 == c0) s += dsk[c0];
        mt[k * 256 + (idx & 255)] = s; }
    __syncthreads();
}
__device__ __forceinline__ void ssm_stage2(const Args& a, int zq, int unit, LAS unsigned char* lds, const int tid) {
    const int lg = unit >> 3, rs = unit & 7;
    LAS float* Ar = (LAS float*)lds; LAS float* Ai = Ar + 65 * 64; LAS float* bbr = Ai + 65 * 64; LAS float* bbi = bbr + 1024; LAS float* cr = bbi + 1024; LAS float* ci = cr + 1024; LAS float* Mt = ci + 1024;
    ssm_setup(a, zq, lg, Ar, Ai, bbr, bbi, cr, ci, tid);
    const float* mt = (const float*)((a.ws + zq) + WS_MTAB) + (size_t)lg * 64 * 256;
    for (int idx = tid; idx < (8 * rs + 8) * 256; idx += NTHR) Mt[idx] = mt[idx];
    __syncthreads();
    bf16_t* Wt = (bf16_t*)((a.ws + zq) + WS_WSSM) + (size_t)lg * 1024 * KSSM;
    for (int idx = tid; idx < 128 * 144; idx += NTHR) { const int row = 128 * rs + idx / 144, cc = idx % 144, j = row >> 4, c1 = row & 15; float v[8];
        if (cc < 128) { const int s = cc >> 1, c0 = (cc & 1) * 8;
#pragma unroll
            for (int i = 0; i < 8; ++i) v[i] = (s <= j) ? Mt[(j - s) * 256 + c1 * 16 + c0 + i] : 0.f;
        } else { const int q0 = (cc - 128) * 8;
#pragma unroll
            for (int i = 0; i < 8; ++i) { const int q = q0 + i, p = q & 63; const float xr = cr[c1 * 64 + p], xi = ci[c1 * 64 + p], ar = Ar[(j + 1) * 64 + p], ai = Ai[(j + 1) * 64 + p];
                v[i] = (q < 64) ? (xr * ar - xi * ai) : -(xr * ai + xi * ar); } }
        u32x4 o; o.x = pk2(v[0], v[1]); o.y = pk2(v[2], v[3]); o.z = pk2(v[4], v[5]); o.w = pk2(v[6], v[7]);
        *(u32x4*)(Wt + (size_t)row * KSSM + cc * 8) = o; }
    bf16_t* Gt = (bf16_t*)((a.ws + zq) + WS_GSSM) + (size_t)lg * 256 * 1024;
    for (int idx = tid; idx < 32 * 128; idx += NTHR) { const int r = idx >> 7, cc = idx & 127, q = (r < 16) ? 16 * rs + r : 128 + 16 * rs + (r - 16); float v[8];
        if (q < 128) { const int s = cc >> 1, c0 = (cc & 1) * 8, p = q & 63; const float ar = Ar[(63 - s) * 64 + p], ai = Ai[(63 - s) * 64 + p];
#pragma unroll
            for (int i = 0; i < 8; ++i) { const float br = bbr[p * 16 + c0 + i], bi = bbi[p * 16 + c0 + i]; v[i] = (q < 64) ? (ar * br - ai * bi) : (ar * bi + ai * br); }
        } else {
#pragma unroll
            for (int i = 0; i < 8; ++i) v[i] = 0.f; }
        u32x4 o; o.x = pk2(v[0], v[1]); o.y = pk2(v[2], v[3]); o.z = pk2(v[4], v[5]); o.w = pk2(v[6], v[7]);
        *(u32x4*)(Gt + (size_t)q * 1024 + cc * 8) = o; }
    __syncthreads();
}

__device__ __forceinline__ void xprep(const Args& a, int zq, int mode, int gw, int ngw, int lane) {
    const float* xs = a.in[I_X + zq]; const unsigned char* slab = (a.ws + zq) + WS_SLAB;
    bf16_t* xb = (bf16_t*)((a.ws + zq) + WS_XB); float* rinv = (float*)((a.ws + zq) + WS_RINV); float* flog = (float*)((a.ws + zq) + WS_FLOG);
    const float* wf = (const float*)((a.ws + zq) + WS_WF) + (mode == 1 ? 4 * DM : 0);
    f32x4 wq[4][4];
    if (mode != 2) {
#pragma unroll
        for (int q = 0; q < 4; ++q)
#pragma unroll
            for (int j = 0; j < 4; ++j) wq[q][j] = *(const f32x4*)(wf + q * DM + 4 * lane + 256 * j);
    }
    for (int row0 = gw; row0 < NTOK; row0 += 2 * ngw) {
        f32x4 v[2][4];
#pragma unroll
        for (int r = 0; r < 2; ++r) { const int row = row0 + r * ngw;
            if (row < NTOK) {
                if (mode == 0) {
#pragma unroll
                    for (int j = 0; j < 4; ++j) v[r][j] = *(const f32x4*)(xs + (size_t)row * DM + 4 * lane + 256 * j);
                } else {
                    u32x2 wx[4]; unsigned ws_[4][4];
#pragma unroll
                    for (int j = 0; j < 4; ++j) wx[j] = *(const u32x2*)(xb + (size_t)row * DM + 4 * lane + 256 * j);
#pragma unroll
                    for (int s = 0; s < 4; ++s)
#pragma unroll
                        for (int j = 0; j < 4; ++j) ws_[s][j] = *(const unsigned*)(slab + ((size_t)row * 4 + s) * DM + 4 * lane + 256 * j);
#pragma unroll
                    for (int j = 0; j < 4; ++j) { f32x4 sm = {0.f, 0.f, 0.f, 0.f};
#pragma unroll
                        for (int s = 0; s < 4; ++s) { const f32x2 lo = __builtin_amdgcn_cvt_pk_f32_fp8((int)ws_[s][j], false), hi = __builtin_amdgcn_cvt_pk_f32_fp8((int)ws_[s][j], true); sm = sm + (f32x4){lo[0], lo[1], hi[0], hi[1]}; }
                        v[r][j] = (f32x4){bflo(wx[j].x), bfhi(wx[j].x), bflo(wx[j].y), bfhi(wx[j].y)} + sm * SLAB_UNSCALE; }
                }
            } else {
#pragma unroll
                for (int j = 0; j < 4; ++j) v[r][j] = (f32x4){0.f, 0.f, 0.f, 0.f};
            } }
        if (mode == 2) {
#pragma unroll
            for (int r = 0; r < 2; ++r) { const int row = row0 + r * ngw; if (row < NTOK) {
#pragma unroll
                for (int j = 0; j < 4; ++j) *(f32x4*)(a.out + (size_t)row * DM + 4 * lane + 256 * j) = v[r][j]; } }
            continue; }
        float red[2][5];
#pragma unroll
        for (int r = 0; r < 2; ++r) { const int row = row0 + r * ngw; float ss = 0.f;
#pragma unroll
            for (int j = 0; j < 4; ++j) { ss += (v[r][j][0] * v[r][j][0] + v[r][j][1] * v[r][j][1]) + (v[r][j][2] * v[r][j][2] + v[r][j][3] * v[r][j][3]);
                if (row < NTOK) { u32x2 w; w.x = pk2(v[r][j][0], v[r][j][1]); w.y = pk2(v[r][j][2], v[r][j][3]); *(u32x2*)(xb + (size_t)row * DM + 4 * lane + 256 * j) = w; } }
            red[r][0] = ss;
#pragma unroll
            for (int q = 0; q < 4; ++q) { float d = 0.f;
#pragma unroll
                for (int j = 0; j < 4; ++j) d += (v[r][j][0] * wq[q][j][0] + v[r][j][1] * wq[q][j][1]) + (v[r][j][2] * wq[q][j][2] + v[r][j][3] * wq[q][j][3]);
                red[r][1 + q] = d; } }
#pragma unroll
        for (int o = 1; o < 64; o <<= 1)
#pragma unroll
            for (int r = 0; r < 2; ++r)
#pragma unroll
                for (int q = 0; q < 5; ++q) red[r][q] += __shfl_xor(red[r][q], o);
#pragma unroll
        for (int r = 0; r < 2; ++r) { const int row = row0 + r * ngw; const float rs = 1.0f / sqrtf(red[r][0] * (1.0f / DM) + EPS);
            if (lane == 0 && row < NTOK) { rinv[row] = rs; *(f32x4*)(flog + (size_t)row * 4) = (f32x4){red[r][1] * rs, red[r][2] * rs, red[r][3] * rs, red[r][4] * rs}; } }
    }
}

#define XB_TMO      128
#define XB_XCNT(j)  (256  + 64 * (j))
#define XB_XSUB(j)  (1280 + 64 * (j))
#define XB_XGEN(j)  (2304 + 64 * (j))
#define XB_TOP      3328
#define XB_TOPGEN   3392
#define XCD_BAR_WORDS 3456
#define XB_SPIN_CAP (1u << 20)
__device__ __forceinline__ unsigned xb_ld(unsigned* p)              { return __hip_atomic_load(p, __ATOMIC_RELAXED, __HIP_MEMORY_SCOPE_AGENT); }
__device__ __forceinline__ unsigned xb_add(unsigned* p, unsigned v) { return __hip_atomic_fetch_add(p, v, __ATOMIC_RELAXED, __HIP_MEMORY_SCOPE_AGENT); }
__device__ __forceinline__ unsigned xb_xcc_id() { return (unsigned)__builtin_amdgcn_s_getreg((3 << 11) | 20) & 0xFu; }
#define XB_SPIN(cond, bar) do { unsigned _sp = 0; while (cond) { __builtin_amdgcn_s_sleep(1); \
    if ((++_sp & 255u) == 0u) { if (xb_ld(&(bar)[XB_TMO])) break; if (_sp > XB_SPIN_CAP) { atomicAdd(&(bar)[XB_TMO], 1u); break; } } } } while (0)
struct XcdBarrier { unsigned* bar; unsigned x; volatile LAS unsigned* st; };
__device__ __forceinline__ XcdBarrier xcd_barrier_post(unsigned* bar, volatile LAS unsigned* st) {
    XcdBarrier b; b.bar = bar; b.x = xb_xcc_id(); b.st = st;
    if (threadIdx.x == 0) (void)xb_add(&bar[XB_XCNT(b.x)], 1u);
    return b;
}
__device__ __forceinline__ void xcd_barrier_complete(unsigned* bar, unsigned x, unsigned& nloc, unsigned& nx) {
    const unsigned G = gridDim.x * gridDim.y * gridDim.z;
    unsigned sum, cnt, mine, sp = 0u;
    for (;;) {
        sum = 0u; cnt = 0u; mine = 0u;
#pragma unroll
        for (unsigned j = 0; j < 16; ++j) { const unsigned c = xb_ld(&bar[XB_XCNT(j)]); sum += c; cnt += (c > 0u) ? 1u : 0u; mine = (j == x) ? c : mine; }
        if (sum == G) break;
        __builtin_amdgcn_s_sleep(1);
        if ((++sp & 255u) == 0u) { if (xb_ld(&bar[XB_TMO])) break; if (sp > XB_SPIN_CAP) { atomicAdd(&bar[XB_TMO], 1u); break; } }
    }
    nloc = mine > 0u ? mine : 1u; nx = cnt > 0u ? cnt : 1u;
}
__device__ __forceinline__ void xcd_barrier(const XcdBarrier& b) {
    asm volatile("s_waitcnt vmcnt(0)" ::: "memory");
    __syncthreads();
    if (threadIdx.x == 0) {
        unsigned* bar = b.bar; asm volatile("" : "+s"(bar));
        __builtin_amdgcn_s_waitcnt(0);
        unsigned nloc = b.st[0], nx = b.st[1];
        if (nloc == 0u) { xcd_barrier_complete(bar, b.x, nloc, nx); b.st[0] = nloc; b.st[1] = nx; }
        const unsigned old = xb_add(&bar[XB_XSUB(b.x)], 1u);
        const unsigned gen = old / nloc;
        if (old + 1u == (gen + 1u) * nloc) {
            __builtin_amdgcn_fence(__ATOMIC_RELEASE, "agent");
            asm volatile("s_waitcnt vmcnt(0)" ::: "memory");
            const unsigned og = xb_add(&bar[XB_TOP], 1u);
            const unsigned tg = og / nx;
            if (og + 1u == (tg + 1u) * nx) xb_add(&bar[XB_TOPGEN], 1u);
            else XB_SPIN(xb_ld(&bar[XB_TOPGEN]) == tg, bar);
            __builtin_amdgcn_fence(__ATOMIC_ACQUIRE, "agent");
            xb_add(&bar[XB_XGEN(b.x)], 1u);
            asm volatile("s_waitcnt vmcnt(0)" ::: "memory");
        } else {
            XB_SPIN(xb_ld(&bar[XB_XGEN(b.x)]) == gen, bar);
            __builtin_amdgcn_fence(__ATOMIC_ACQUIRE, "agent");
            asm volatile("s_waitcnt vmcnt(0)" ::: "memory");
        }
    }
    __syncthreads();
}

constexpr int SPLIST[] = {0, 1, 2, 4, 5, 7, 8, 9, 11, 12};
constexpr int PH_PER_LAYER = sizeof(SPLIST) / sizeof(int), N_PHASES = 1 + NLAYER * PH_PER_LAYER;
__host__ __device__ constexpr int sp_of(int ph) { return SPLIST[(ph - 1) % PH_PER_LAYER]; }

template <unsigned MASK> __global__ void __launch_bounds__(NTHR, 2) mk(Args a) {
#define HAS(code) (((MASK) >> (code)) & 1u)
    extern __shared__ __attribute__((aligned(16))) unsigned char lds_raw[];
    LAS unsigned char* lds = (LAS unsigned char*)lds_raw;
    const int G = gridDim.x, bid = blockIdx.x, ngw = G * NWAVES;
#if MK_N_LAUNCHES
    { volatile LAS unsigned* misc = (volatile LAS unsigned*)(lds + MISC_OFF); if (threadIdx.x < 64) misc[threadIdx.x] = 0u; __syncthreads(); }
    XcdBarrier bar = xcd_barrier_post((unsigned*)(a.ws + WS_CTL) + 4096, (volatile LAS unsigned*)(lds + MISC_OFF) + 8);
#endif

#ifndef PROBE_CODE
#define PROBE_CODE -1
#define PROBE_REPS 0
#define PROBE_DRY 1
#endif
#ifndef PROBE_L0ONLY
#define PROBE_L0ONLY 1
#endif
    int probe_rep = 0;
    for (int ph = a.ph_lo; ph < a.ph_hi;) {
        int zq = 0; asm volatile("" : "+s"(zq));
        unsigned char* ws = a.ws + zq;
        int tid = threadIdx.x; asm volatile("" : "+v"(tid));
        const int lane = tid & 63, wave = __builtin_amdgcn_readfirstlane(tid >> 6), gw = bid * NWAVES + wave;
        int cv_limit = 0, cs_end = 0, cs_lo = -1, cs_w0 = gw, cs_nw = ngw; unsigned cv_thr = 0u;
        if (ph == N_PHASES) { if constexpr (HAS(14)) { xprep(a, zq, 2, gw, ngw, lane); } }
        else if (ph == 0) { if constexpr (HAS(0)) {
            LAS float* scr = (LAS float*)(lds + wave * 16640);
            for (int it = gw; it < NLAYER * 784; it += ngw) { const int l = it / 784; int r = it % 784;
                if (r < 384) { const int kb = r / 24, nb = r % 24; tr_item64(a.in[I_WIN + zq] + (size_t)l * DM * INC, INC, 64 * kb, 64 * nb + (nb >= 20 ? 4 : 0), (bf16_t*)(ws + WS_WIN) + (size_t)l * 1536 * DM, DM, 64 * nb, a.in[I_MIXG + zq] + l * DM, scr, lane); continue; } r -= 384;
                if (r < 128) { const int kb = r / 8, nb = r % 8; tr_item64(a.in[I_MWKV + zq] + (size_t)l * DM * 512, 512, 64 * kb, 64 * nb, (bf16_t*)(ws + WS_WKV) + (size_t)l * 512 * DM, DM, 64 * nb, a.in[I_MNG + zq] + l * DM, scr, lane); continue; } r -= 128;
                if (r < 256) { const int kb = r / 16, nb = r % 16; const int gsel = kb >> 2;
                    const float* gain = (gsel == 0 ? a.in[I_SOUTG + zq] : gsel == 1 ? a.in[I_POOLS + zq] : gsel == 2 ? a.in[I_FOUTG + zq] : a.in[I_MOUTG + zq]) + l * 256 - 256 * gsel;
                    tr_item64(a.in[I_WOUT + zq] + (size_t)l * DM * DM, DM, 64 * kb, 64 * nb, (bf16_t*)(ws + WS_WOUT) + (size_t)l * DM * DM, DM, 64 * nb, gain, scr, lane); continue; } r -= 256;
                { const int kb = r / 4, nb = r % 4; tr_item64(a.in[I_GLUW + zq] + (size_t)l * 65536, 256, 64 * kb, 64 * nb, (bf16_t*)(ws + WS_WGLU) + (size_t)l * 65536, 256, 64 * nb, nullptr, scr, lane); }
            }
            for (int idx = bid * NTHR + tid; idx < NLAYER * 256 * DM; idx += G * NTHR) { const int l = idx / (256 * DM), r = idx % (256 * DM), n = r / DM, k = r % DM;
                const float v = (n < 32) ? a.in[I_RW + zq][(size_t)l * DM * 32 + (size_t)k * 32 + n] * a.in[I_FFNG + zq][l * DM + k] : 0.f;
                ((bf16_t*)(ws + WS_WR))[idx] = (bf16_t)f2bf(v); }
            for (int idx = bid * NTHR + tid; idx < NLAYER * 65536; idx += G * NTHR) { const int l = idx >> 16, r = idx & 65535, n = r >> 8, k = r & 255, gi = n >> 6;
                const float v = ((k >> 6) == gi) ? a.in[I_POOLW + zq][(size_t)l * 16384 + gi * 4096 + (k & 63) * 64 + (n & 63)] : 0.f;
                ((bf16_t*)(ws + WS_WPOOL))[idx] = (bf16_t)f2bf(v); }
            for (int idx = bid * NTHR + tid; idx < NLAYER * 4 * DM; idx += G * NTHR) { const int l = idx / (4 * DM), r = idx % (4 * DM), q = r / DM, k = r % DM;
                ((float*)(ws + WS_WF))[idx] = a.in[I_WIN + zq][(size_t)l * DM * INC + (size_t)k * INC + 1280 + q] * a.in[I_MIXG + zq][l * DM + k]; }
            for (int row = gw; row < NMEM; row += ngw) { f32x4 v[4]; float ss = 0.f;
#pragma unroll
                for (int j = 0; j < 4; ++j) { v[j] = *(const f32x4*)(a.in[I_MEM + zq] + (size_t)row * DM + 4 * lane + 256 * j); ss += (v[j][0] * v[j][0] + v[j][1] * v[j][1]) + (v[j][2] * v[j][2] + v[j][3] * v[j][3]);
                    u32x2 w; w.x = pk2(v[j][0], v[j][1]); w.y = pk2(v[j][2], v[j][3]); *(u32x2*)((bf16_t*)(ws + WS_MEMB) + (size_t)row * DM + 4 * lane + 256 * j) = w; }
                const float rs = 1.0f / sqrtf(wave_sum(ss) * (1.0f / DM) + EPS); if (lane == 0) ((float*)(ws + WS_RINVM))[row] = rs; }
            cs_end = G > 64 ? CONV_P0K : CNIT; cs_lo = 0;
        } } else {
            const int l = (ph - 1) / PH_PER_LAYER, sp = sp_of(ph);
            if (sp == 0) { if constexpr (HAS(1)) {
                _Pragma("unroll 1") for (int pass = 0; pass < 2; ++pass) {
                    const int odd = (bid >> 3) & 1;
                    if (l == 0 && pass == 1 - odd) { __syncthreads(); for (int u = bid; u < NLAYER * 16 * 8; u += G) ssm_stage2(a, zq, u, lds, tid); __syncthreads(); }
                    else if (pass == (l == 0 ? odd : 0)) xprep(a, zq, l == 0 ? 0 : 1, gw, ngw, lane); }
            } } else if (sp == 1) { if constexpr (HAS(2)) {
                pg8::DenseSched S; S.init(ws + WS_XB, DM, 0, ws + WS_WIN + (size_t)l * 1536 * DM * 2, DM, 0, NTOK, 1536, 1, G, bid);
                pg8::EpiInProj E{(const float*)(ws + WS_RINV), ws};
                pg8::gemm_phase(lds, DM, S, E);
                if (l == 0) { pg8::DenseSched S2; S2.init(ws + WS_MEMB, DM, 0, ws + WS_WKV, DM, (size_t)512 * DM * 2, NMEM, 512, 2, G, G - 1 - bid);
                    pg8::EpiKv E2{(const float*)(ws + WS_RINVM), (bf16_t*)(ws + WS_KVRAW)}; pg8::gemm_phase(lds, DM, S2, E2);
                    if (G > 64 && CONV_P0K < CONV_P0S && G - 1 - bid >= S2.nwg) { cs_lo = CONV_P0K; cs_end = CONV_P0S; cs_w0 = bid * NWAVES + wave; cs_nw = (G - S2.nwg) * NWAVES; } }
            } } else if (sp == 2) { if constexpr (HAS(3)) {
                bf16_t* qb = (bf16_t*)(ws + WS_Q); bf16_t* kb = (bf16_t*)(ws + WS_K); bf16_t* qmb = (bf16_t*)(ws + WS_QM); const bf16_t* ub = (const bf16_t*)(ws + WS_UB); bf16_t* dp = (bf16_t*)(ws + WS_DP);
                const int d0 = (4 * lane) & 63;
                const f32x4 gq = *(const f32x4*)(a.in[I_FQG + zq] + l * 64 + d0) * C2, gk = *(const f32x4*)(a.in[I_FKG + zq] + l * 64 + d0), gm = *(const f32x4*)(a.in[I_MQG + zq] + l * 64 + d0) * C2;
                { const int rstep = G > 64 ? (G - 32) * NWAVES : ngw; const int wsel = lane >> 4;
                  for (int run = (G > 64 && bid >= G - 32) ? NTOK / 16 : gw; run < NTOK / 16; run += rstep) { const int r0 = run * 16, pos0 = r0 & (SEQ - 1);
                    u32x2 cur[16], prv[16];
#pragma unroll
                    for (int k = 0; k < 16; ++k) { cur[k] = *(const u32x2*)(ub + (size_t)(r0 + k) * 256 + 4 * lane); prv[k] = *(const u32x2*)(ub + (size_t)(pos0 ? r0 - 16 + k : r0 + k) * 256 + 4 * lane); }
                    if (pos0 == 0) {
#pragma unroll
                        for (int k = 0; k < 16; ++k) prv[k] = (u32x2){0u, 0u}; }
#define MP_F4(w_) ((f32x4){bflo((w_).x), bfhi((w_).x), bflo((w_).y), bfhi((w_).y)})
                    f32x4 sw[4];
#pragma unroll
                    for (int q = 0; q < 4; ++q) { sw[q] = (f32x4){0.f, 0.f, 0.f, 0.f};
#pragma unroll
                        for (int m = 16 - (2 << q); m < 16; ++m) sw[q] = sw[q] + MP_F4(prv[m]); }
#pragma unroll
                    for (int i = 0; i < 16; ++i) { const f32x4 vi = MP_F4(cur[i]);
#pragma unroll
                        for (int q = 0; q < 4; ++q) { const int w_ = 2 << q; const int j = i - w_;
                            const f32x4 out = j >= 0 ? MP_F4(cur[j >= 0 ? j : 0]) : MP_F4(prv[j < 0 ? 16 + j : 0]); sw[q] = sw[q] + vi - out; }
                        const f32x4 ssel = wsel == 0 ? sw[0] : wsel == 1 ? sw[1] : wsel == 2 ? sw[2] : sw[3];
                        const int pos = pos0 + i, wlen = 2 << wsel, cnt = (pos + 1) < wlen ? (pos + 1) : wlen;
                        const f32x4 d = ssel * (1.0f / (float)cnt) - vi; u32x2 o; o.x = pk2(d[0], d[1]); o.y = pk2(d[2], d[3]); *(u32x2*)(dp + (size_t)(r0 + i) * 256 + 4 * lane) = o; }
#pragma unroll
                    for (int which = 0; which < 3; ++which) { bf16_t* base = which == 0 ? qb : which == 1 ? kb : qmb; const f32x4 gg = which == 0 ? gq : which == 1 ? gk : gm;
                        u32x2 wv[16];
#pragma unroll
                        for (int k = 0; k < 16; ++k) wv[k] = *(const u32x2*)(base + (size_t)(r0 + k) * 256 + 4 * lane);
#pragma unroll
                        for (int k = 0; k < 16; ++k) { f32x4 v = MP_F4(wv[k]);
                            float ss = (v[0] * v[0] + v[1] * v[1]) + (v[2] * v[2] + v[3] * v[3]); ss += __shfl_xor(ss, 1); ss += __shfl_xor(ss, 2); ss += __shfl_xor(ss, 4); ss += __shfl_xor(ss, 8);
                            const float rs = 1.0f / sqrtf(ss * (1.0f / 64.0f) + EPS); v = v * gg * rs; u32x2 o; o.x = pk2(v[0], v[1]); o.y = pk2(v[2], v[3]);
                            *(u32x2*)(base + (size_t)(r0 + k) * 256 + 4 * lane) = o; } }
#undef MP_F4
                  } }
                if (l == 0) {
                    for (int r2 = (G > 64 && bid >= G - 32) ? NLAYER * NMEM : gw; r2 < NLAYER * NMEM; r2 += (G > 64 ? (G - 32) * NWAVES : ngw)) { const int ll = r2 / NMEM, row = r2 % NMEM; const bf16_t* src = (const bf16_t*)(ws + WS_KVRAW) + ((size_t)ll * NMEM + row) * 512;
                        const f32x4 gg = *(const f32x4*)(a.in[I_MKG + zq] + ll * 64 + d0);
                        const u32x2 w = *(const u32x2*)(src + 4 * lane); f32x4 v = {bflo(w.x), bfhi(w.x), bflo(w.y), bfhi(w.y)};
                        float ss = (v[0] * v[0] + v[1] * v[1]) + (v[2] * v[2] + v[3] * v[3]); ss += __shfl_xor(ss, 1); ss += __shfl_xor(ss, 2); ss += __shfl_xor(ss, 4); ss += __shfl_xor(ss, 8);
                        const float rs = 1.0f / sqrtf(ss * (1.0f / 64.0f) + EPS); v = v * gg * rs; u32x2 o; o.x = pk2(v[0], v[1]); o.y = pk2(v[2], v[3]);
                        *(u32x2*)((bf16_t*)(ws + WS_MK) + ((size_t)ll * NMEM + row) * 256 + 4 * lane) = o;
                        *(u32x2*)((bf16_t*)(ws + WS_MV) + ((size_t)ll * NMEM + row) * 256 + 4 * lane) = *(const u32x2*)(src + 256 + 4 * lane); } }
                for (int u = bid; u < 32; u += G) { const int b = u >> 2, h = u & 3; const float fb = a.in[I_FFB + zq][l * 4 + h]; const float* fl = (const float*)(ws + WS_FLOG);
                    float v[8], run = 0.f;
#pragma unroll
                    for (int i = 0; i < 8; ++i) { const float x = fl[((size_t)b * SEQ + tid * 8 + i) * 4 + h] + fb; const float ls = fminf(x, 0.f) - log1pf(__expf(-fabsf(x))); run += ls * LOG2E; v[i] = run; }
                    float inc = run;
#pragma unroll
                    for (int o = 1; o < 64; o <<= 1) { const float t = __shfl_up(inc, o); if (lane >= o) inc += t; }
                    LAS float* wt = (LAS float*)lds;
                    __syncthreads(); if (lane == 63) wt[wave] = inc; __syncthreads();
                    float base = inc - run; for (int w = 0; w < wave; ++w) base += wt[w];
                    float* ck = (float*)(ws + WS_CK) + (size_t)u * SEQ + tid * 8;
#pragma unroll
                    for (int i = 0; i < 8; ++i) ck[i] = base + v[i];
                    __syncthreads(); }
                { pg8::DenseSched S; S.init(ws + WS_UEXT, KSSM, (size_t)NCHUNK * KSSM * 2, ws + WS_GSSM + (size_t)l * 16 * 256 * 1024 * 2, 1024, (size_t)256 * 1024 * 2, NCHUNK, 256, 16, G, G - 1 - bid);
                  pg8::EpiS E{(float*)(ws + WS_S)}; pg8::gemm_phase(lds, 1024, S, E); }
                if (MIXPREP_HOST) { const int nl = G > 64 ? 32 : G; HOST_NOTE(); if (G - 1 - bid >= nl) { cv_limit = 2 * CNIT; cv_thr = HOST_THR(l == 0 ? 0 : 4, nl);
                    if (l == 0 && CONV_P0S < CNIT) { cs_lo = CONV_P0S; cs_end = CNIT; cs_w0 = bid * NWAVES + wave; cs_nw = (G - nl) * NWAVES; } } }
                { const int cs = G - 1 - bid;
                  if (cs < 32) { const int wg = pg8::xcd_remap(cs, 32), g = wg >> 1, pm = wg & 1;
                    VM_WAIT(); __syncthreads();
                    if (tid < 256) { const int p = tid & 63, b = 4 * pm + (tid >> 6); const int lg = l * 16 + g;
                        const float* Sg = (const float*)(ws + WS_S) + ((size_t)g * NCHUNK + b * 64) * 128 + p; bf16_t* H = (bf16_t*)(ws + WS_UEXT) + ((size_t)g * NCHUNK + b * 64) * KSSM + 1024 + p;
                        float sr[64], si[64];
#pragma unroll
                        for (int c = 0; c < 64; ++c) { sr[c] = Sg[(size_t)c * 128]; si[c] = Sg[(size_t)c * 128 + 64]; }
                        float ar, ai; apow(a.in[I_LRE + zq][lg * 64 + p], a.in[I_LIM + zq][lg * 64 + p], expf(a.in[I_LDT + zq][lg]), 64, ar, ai);
                        float hr = 0.f, hi_ = 0.f;
#pragma unroll
                        for (int c = 0; c < 64; ++c) { H[(size_t)c * KSSM] = (bf16_t)f2bf(hr); H[(size_t)c * KSSM + 64] = (bf16_t)f2bf(hi_);
                            const float nr = ar * hr - ai * hi_ + sr[c], ni = ar * hi_ + ai * hr + si[c]; hr = nr; hi_ = ni; } } } }
            } } else if (sp == 4) { if constexpr (HAS(5)) {
                const int kc = ((G & 7) == 0 && G >= 64) ? MIX_KC : 0, Ge = G - kc;
                if (bid >= Ge) { HOST_NOTE(); cv_limit = 2 * CNIT; cv_thr = HOST_THR(l == 0 ? 1 : 5, G - kc); }
                else {
                { pg8::DenseSched S; S.init(ws + WS_UEXT, KSSM, (size_t)NCHUNK * KSSM * 2, ws + WS_WSSM + (size_t)l * 16 * 1024 * KSSM * 2, KSSM, (size_t)1024 * KSSM * 2, NCHUNK, 1024, 16, Ge, bid);
                  pg8::EpiY E{(bf16_t*)(ws + WS_Z)}; pg8::gemm_phase(lds, KSSM, S, E); }
                { pg8::DenseSched S; S.init(ws + WS_DP, 256, 0, ws + WS_WPOOL + (size_t)l * 65536 * 2, 256, 0, NTOK, 256, 1, Ge, Ge - 1 - bid);
                  pg8::EpiPool E{(bf16_t*)(ws + WS_MERGED), (float*)(ws + WS_SSQ)}; pg8::gemm_phase(lds, 256, S, E); }
                float skipthr;
                { float mq = fabsf(a.in[I_FQG + zq][l * 64 + lane]), mk2 = fabsf(a.in[I_FKG + zq][l * 64 + lane]);
#pragma unroll
                  for (int o = 1; o < 64; o <<= 1) { mq = fmaxf(mq, __shfl_xor(mq, o)); mk2 = fmaxf(mk2, __shfl_xor(mk2, o)); }
                  skipthr = 2.0f * 1.02f * (64.0f * C2 * mq * mk2) + 72.0f; }
                { unsigned* ctr = (unsigned*)(ws + WS_CTL) + 8192 + 64 * l; volatile LAS int* qslot = (volatile LAS int*)(lds + MISC_OFF + 64); bool posted = false;
                  for (;;) {
                    __syncthreads(); if (tid == 0) *qslot = (int)__hip_atomic_fetch_add(ctr, 1u, __ATOMIC_RELAXED, __HIP_MEMORY_SCOPE_AGENT); __syncthreads();
                    const int uq = *qslot;
                    if (!posted && uq >= 1024 - Ge) { HOST_NOTE(); posted = true; }
                    if (uq >= 1024) break;
                    if (uq < 512) { const int qbk = 15 - (uq >> 5), b = (uq >> 2) & 7, h = uq & 3;
                        attn_body::attn_unit<8>(b, h, qbk, (const attn_body::bf16*)(ws + WS_Q), (const attn_body::bf16*)(ws + WS_K), (const attn_body::bf16*)(ws + WS_V), (attn_body::bf16*)(ws + WS_MERGED) + 512 + h * 64,
                                                (const float*)(ws + WS_CK) + (size_t)(b * 4 + h) * SEQ, (float*)(ws + WS_SSQ) + 8 + h, (char*)lds_raw, skipthr);
                    } else { const int m = uq - 512, b = m >> 6, h = (m >> 4) & 3, qbk = m & 15; const size_t qrow0 = (size_t)b * SEQ + qbk * 256;
                        att::unit(lds, (const bf16_t*)(ws + WS_QM), qrow0, (const bf16_t*)(ws + WS_MK) + (size_t)l * NMEM * 256, (const bf16_t*)(ws + WS_MV) + (size_t)l * NMEM * 256, (size_t)b * MEMLEN, h * 64, nullptr,
                                  4, false, (bf16_t*)(ws + WS_MERGED) + 768 + h * 64, (float*)(ws + WS_SSQ) + 12 + h); } } }
                }
            } } else if (sp == 5) { if constexpr (HAS(6)) {
                pg8::DenseSched S; S.init(ws + WS_Z, 256, 0, ws + WS_WGLU + (size_t)l * 65536 * 2, 256, 0, NTOK, 256, 1, G, bid);
                pg8::EpiGlu E{(const bf16_t*)(ws + WS_Z), a.in[I_GLUB + zq] + l * 256, (bf16_t*)(ws + WS_MERGED), (LAS float*)(lds + GLU_TAB_OFF)}; pg8::gemm_phase(lds, 256, S, E);
                { const int nn = G > 128 ? G - 128 : G, nb0 = G > 128 ? bid - 128 : bid;
                  if (nb0 >= 0 && lane < 48) { bf16_t* mg = (bf16_t*)(ws + WS_MERGED); const float* ssq = (const float*)(ws + WS_SSQ); const int rstep = nn * NWAVES;
                    for (int row0 = nb0 * NWAVES + wave; row0 < NTOK; row0 += 4 * rstep) {
                        f32x4 sp4[4]; u32x4 w[4][2];
#pragma unroll
                        for (int r = 0; r < 4; ++r) { const int row = (row0 + r * rstep) < NTOK ? (row0 + r * rstep) : NTOK - 1;
                            sp4[r] = *(const f32x4*)(ssq + (size_t)row * 16 + 4 + (lane >> 4) * 4);
#pragma unroll
                            for (int j = 0; j < 2; ++j) w[r][j] = *(const u32x4*)(mg + (size_t)row * DM + 256 + 16 * lane + 8 * j); }
#pragma unroll
                        for (int r = 0; r < 4; ++r) { const int row = row0 + r * rstep; if (row < NTOK) { const float rs = 1.0f / sqrtf(((sp4[r][0] + sp4[r][1]) + (sp4[r][2] + sp4[r][3])) * (1.0f / 256.0f) + EPS);
#pragma unroll
                            for (int j = 0; j < 2; ++j) { const u32x4 ww = w[r][j];
                                const f32x4 v0 = (f32x4){bflo(ww.x), bfhi(ww.x), bflo(ww.y), bfhi(ww.y)} * rs, v1 = (f32x4){bflo(ww.z), bfhi(ww.z), bflo(ww.w), bfhi(ww.w)} * rs;
                                *(u32x4*)(mg + (size_t)row * DM + 256 + 16 * lane + 8 * j) = pg8::pack8(v0, v1); } } } } } }
            } } else if (sp == 6) { if constexpr (HAS(7)) {
                bf16_t* mg = (bf16_t*)(ws + WS_MERGED); const float* ssq = (const float*)(ws + WS_SSQ);
                for (int row = gw; row < NTOK; row += ngw) { const f32x4 sp4 = *(const f32x4*)(ssq + (size_t)row * 16 + (lane >> 4) * 4);
                    const float rs = 1.0f / sqrtf(((sp4[0] + sp4[1]) + (sp4[2] + sp4[3])) * (1.0f / 256.0f) + EPS);
#pragma unroll
                    for (int j = 0; j < 2; ++j) { bf16_t* p = mg + (size_t)row * DM + 16 * lane + 8 * j; const u32x4 w = *(const u32x4*)p;
                        const f32x4 v0 = (f32x4){bflo(w.x), bfhi(w.x), bflo(w.y), bfhi(w.y)} * rs, v1 = (f32x4){bflo(w.z), bfhi(w.z), bflo(w.w), bfhi(w.w)} * rs; *(u32x4*)p = pg8::pack8(v0, v1); } }
            } } else if (sp == 7) { if constexpr (HAS(8)) {
                pg8::DenseSched S; S.init(ws + WS_MERGED, DM, 0, ws + WS_WOUT + (size_t)l * DM * DM * 2, DM, 0, NTOK, DM, 1, G, bid);
                pg8::EpiWout E{(bf16_t*)(ws + WS_XB), (float*)(ws + WS_SSQ2)}; pg8::gemm_phase(lds, DM, S, E);
            } } else if (sp == 8) { if constexpr (HAS(9)) {
                pg8::DenseSched S; S.init(ws + WS_XB, DM, (size_t)1024, ws + WS_WR + (size_t)l * 256 * DM * 2, DM, (size_t)1024, NTOK, 256, 2, G, bid);
                pg8::EpiRouter E{(float*)(ws + WS_LOGITP)}; pg8::gemm_phase(lds, DM / 2, S, E);
            } } else if (sp == 9) { if constexpr (HAS(10)) {
                LAS int* cntw = (LAS int*)lds;
                const int ntk = NTOK / NTHR;
                for (int tg = bid; tg < ntk; tg += G) { const int t = tg * NTHR + tid;
                    const f32x4* p0 = (const f32x4*)((const float*)(ws + WS_LOGITP) + (size_t)t * 32); const f32x4* p1 = (const f32x4*)((const float*)(ws + WS_LOGITP) + ((size_t)NTOK + t) * 32);
                    const f32x4* sq = (const f32x4*)((const float*)(ws + WS_SSQ2) + (size_t)t * 16); const f32x4* rbp = (const f32x4*)(a.in[I_RB + zq] + l * 32);
                    float ss = 0.f;
#pragma unroll
                    for (int i = 0; i < 4; ++i) { const f32x4 q = sq[i]; ss += (q[0] + q[1]) + (q[2] + q[3]); }
                    const float rs = 1.0f / sqrtf(ss * (1.0f / DM) + EPS);
                    float v[32];
#pragma unroll
                    for (int i = 0; i < 8; ++i) { const f32x4 x = (p0[i] + p1[i]) * rs + rbp[i]; v[4 * i] = x[0]; v[4 * i + 1] = x[1]; v[4 * i + 2] = x[2]; v[4 * i + 3] = x[3]; }
                    float val[4]; int idx[4];
#pragma unroll
                    for (int k = 0; k < 4; ++k) { float best = v[0]; int bi = 0;
#pragma unroll
                        for (int i = 1; i < 32; ++i) if (v[i] > best) { best = v[i]; bi = i; }
                        val[k] = best; idx[k] = bi;
#pragma unroll
                        for (int i = 0; i < 32; ++i) v[i] = (i == bi) ? -INFINITY : v[i]; }
                    float e1 = __expf(val[1] - val[0]), e2 = __expf(val[2] - val[0]), e3 = __expf(val[3] - val[0]); const float inv = 1.0f / (1.0f + e1 + e2 + e3);
                    const float gate[4] = {inv, e1 * inv, e2 * inv, e3 * inv};
                    int rk[4]; const unsigned long long lt = (1ull << lane) - 1ull;
                    __syncthreads();
#pragma unroll
                    for (int s = 0; s < 4; ++s) { int myc = 0; rk[s] = 0;
                        _Pragma("unroll 1") for (int e = 0; e < 32; ++e) { const unsigned long long mk_ = __ballot(idx[s] == e); if (idx[s] == e) rk[s] = __popcll(mk_ & lt); if (lane == e) myc = __popcll(mk_); }
                        if (lane < 32) cntw[(wave * 4 + s) * 32 + lane] = myc; }
                    __syncthreads();
                    *(f32x4*)((float*)(ws + WS_TKGATE) + (size_t)t * 4) = (f32x4){gate[0], gate[1], gate[2], gate[3]};
#pragma unroll
                    for (int s = 0; s < 4; ++s) { int base = 0; _Pragma("unroll 1") for (int q = 0; q < wave * 4 + s; ++q) base += cntw[q * 32 + idx[s]];
                        { u32x2 ent_; ent_.x = (unsigned)(t * 4 + s); ent_.y = __builtin_bit_cast(unsigned, gate[s]); ((u32x2*)(ws + WS_TGLIST))[((size_t)tg * 32 + idx[s]) * 512 + base + rk[s]] = ent_; } }
                    if (tid < 32) { int tot = 0; _Pragma("unroll 1") for (int q = 0; q < 32; ++q) tot += cntw[q * 32 + tid]; ((int*)(ws + WS_HIST))[tg * 32 + tid] = tot; }
                }
                { const int nconv = G > ntk ? G - ntk : G, cb = G > ntk ? bid - ntk : bid;
                  if (cb >= 0) { const bf16_t* xb = (const bf16_t*)(ws + WS_XB); unsigned char* x8 = ws + WS_X8; const float* ssq2 = (const float*)(ws + WS_SSQ2); const int rstep = nconv * NWAVES;
                    for (int row0 = cb * NWAVES + wave; row0 < NTOK; row0 += 4 * rstep) {
                        float sv[4]; u32x4 w[4][2];
#pragma unroll
                        for (int r = 0; r < 4; ++r) { const int row = (row0 + r * rstep) < NTOK ? (row0 + r * rstep) : NTOK - 1; sv[r] = ssq2[(size_t)row * 16 + (lane & 15)]; sv[r] = (lane < 16) ? sv[r] : 0.f;
#pragma unroll
                            for (int j = 0; j < 2; ++j) w[r][j] = *(const u32x4*)(xb + (size_t)row * DM + 8 * lane + 512 * j); }
#pragma unroll
                        for (int o = 1; o < 16; o <<= 1)
#pragma unroll
                            for (int r = 0; r < 4; ++r) sv[r] += __shfl_xor(sv[r], o);
#pragma unroll
                        for (int r = 0; r < 4; ++r) { const int row = row0 + r * rstep; const float rs = 1.0f / sqrtf(__shfl(sv[r], 0) * (1.0f / DM) + EPS);
                            if (row < NTOK) {
#pragma unroll
                                for (int j = 0; j < 2; ++j) { const u32x4 ww = w[r][j];
                                    u32x2 o; o.x = pk4_fp8(bflo(ww.x) * rs, bfhi(ww.x) * rs, bflo(ww.y) * rs, bfhi(ww.y) * rs); o.y = pk4_fp8(bflo(ww.z) * rs, bfhi(ww.z) * rs, bflo(ww.w) * rs, bfhi(ww.w) * rs);
                                    *(u32x2*)(x8 + (size_t)row * DM + 8 * lane + 512 * j) = o; } } } } } }
                if (l == 1 || CONV_P0N < CNIT) { cv_limit = l == 0 ? CNIT : 2 * CNIT; cv_thr = 0u; cs_end = cv_limit; }
            } } else if (sp == 10) { if constexpr (HAS(11)) {
                LAS int* tab = (LAS int*)lds;
                const int* hist = (const int*)(ws + WS_HIST);
                __syncthreads();
                if (tid < 32) { int c = 0; _Pragma("unroll 1") for (int q = 0; q < NTOK / NTHR; ++q) c += hist[q * 32 + tid]; tab[tid] = c; }
                __syncthreads();
                if (tid == 0) { int acc = 0; _Pragma("unroll 1") for (int e = 0; e < 32; ++e) { tab[32 + e] = acc; acc += (tab[e] + 255) & ~255; } }
                __syncthreads();
                int* row_tok = (int*)(ws + WS_ROWTOK); int* row_dst = (int*)(ws + WS_ROWDST); float* row_gate = (float*)(ws + WS_ROWGATE); float* row_rinv = (float*)(ws + WS_ROWRINV); const float* rinv2 = (const float*)(ws + WS_RINV2);
                for (int tg = bid; tg < NTOK / NTHR; tg += G) {
                    __syncthreads();
                    if (tid < 32) { int c = tab[32 + tid]; _Pragma("unroll 1") for (int q = 0; q < tg; ++q) c += hist[q * 32 + tid]; tab[64 + tid] = c; }
                    __syncthreads();
                    const int t = tg * NTHR + tid;
#pragma unroll
                    for (int s = 0; s < 4; ++s) { const int e = ((const int*)(ws + WS_TKIDX))[(size_t)t * 4 + s]; const int d = tab[64 + e] + ((const int*)(ws + WS_TKRANK))[(size_t)t * 4 + s];
                        row_tok[d] = t; row_dst[d] = t * 4 + s; row_gate[d] = ((const float*)(ws + WS_TKGATE))[(size_t)t * 4 + s]; row_rinv[d] = rinv2[t]; }
                }
                for (int e = bid; e < 32; e += G) { const int c = tab[e], p0 = tab[32 + e], pe = p0 + ((c + 255) & ~255);
                    for (int r = p0 + c + tid; r < pe; r += NTHR) { row_tok[r] = 0; row_dst[r] = -1; row_gate[r] = 0.f; row_rinv[r] = 0.f; } }
            } } else if (sp == 11 || sp == 12) { if constexpr (HAS(12) || HAS(13)) {
                LAS int* tab = (LAS int*)(lds + MOE_TAB_OFF); LAS unsigned char* mt_e = (LAS unsigned char*)(lds + MOE_TAB_OFF + 512);
                const int* hist = (const int*)(ws + WS_HIST);
                __syncthreads();
                LAS int* pfx = (LAS int*)lds;
                if (sp == 11 || MK_N_LAUNCHES != 1) {
                { const i32x4v h4 = *(const i32x4v*)(hist + 4 * tid); *(LAS i32x4v*)(pfx + 4 * tid) = h4; }
                __syncthreads();
                if (tid < 32) { int c = 0; _Pragma("unroll 8") for (int q = 0; q < NTOK / NTHR; ++q) { const int h = pfx[q * 32 + tid]; pfx[q * 32 + tid] = c; c += h; } tab[64 + tid] = c; tab[tid] = (c + 255) >> 8; }
                __syncthreads();
                if (tid == 0) { int acc = 0; _Pragma("unroll 1") for (int e = 0; e < 32; ++e) { tab[96 + e] = acc; acc += tab[e]; } tab[32] = acc; }
                __syncthreads();
                for (int t = tid; t < tab[32]; t += NTHR) { int e = 0; _Pragma("unroll") for (int q = 1; q < 32; ++q) e += (tab[96 + q] <= t) ? 1 : 0; mt_e[t] = (unsigned char)e; }
                __syncthreads(); }
                const int n_mt = tab[32];
                if (sp == 11) { if constexpr (HAS(12)) {
                    pg8::MoeSched<true> S; S.A = (const char*)(ws + WS_X8); S.B = (const char*)(ws + WS_WGU + (size_t)l * NE * 2048 * DM); S.lda = DM / 2; S.ldb = DM / 2; S.b_es = (size_t)2048 * DM; S.nN = 8; S.n_mt = n_mt; S.mt_e = mt_e; S.row_tok = (const int*)(ws + WS_ROWTOK);
                    const int T = 8 * n_mt, R = (T + G - 1) / G; int kc = 0;
                    if (l == 0 && (G & 7) == 0 && G >= 64) { kc = (((R * G - T) + R - 1) / R + 7) & ~7; kc = kc > 32 ? 32 : kc; }
                    const int Ge = G - kc, Lmain = T < R * Ge ? T : R * Ge; const bool cvb = bid >= Ge;
                    S.G = cvb ? kc : Ge; S.c = cvb ? bid - Ge : bid; S.L0 = cvb ? Lmain : 0; S.Lend = cvb ? T : Lmain;
                    S.note = (l == 0 && !cvb) ? (unsigned long long*)((unsigned*)(ws + WS_CTL) + CQ_WORD) : nullptr;
                    pg8::EpiMoe1 E{a.in[I_EBG + zq] + (size_t)l * NE * DM, a.in[I_EBU + zq] + (size_t)l * NE * DM, ws + WS_H, PROBE_DRY && probe_rep > 0};
                    {
                      int* row_tok = (int*)(ws + WS_ROWTOK); int* row_dst = (int*)(ws + WS_ROWDST); float* row_gate = (float*)(ws + WS_ROWGATE);
                      const u32x2* tglist = (const u32x2*)(ws + WS_TGLIST);
                      LAS int* tl = pfx + 64 * 32;
                      if (tid < 64) { int n = 0;
                          _Pragma("unroll 1") for (int b0 = 0;; b0 += 64) { pg8::Unit uu; uu.pm = 0; const bool has = S.next(b0 + tid, uu); const unsigned long long mk_ = __ballot(has);
                              if (has) tl[1 + n + __popcll(mk_ & ((1ull << tid) - 1ull))] = uu.pm; n += __popcll(mk_); if (mk_ != ~0ull) break; }
                          if (tid == 0) tl[0] = n; }
                      __syncthreads();
                      const int nrows = tl[0] * 256;
                      _Pragma("unroll 1") for (int base = 0; base < nrows; base += 8 * NTHR) {
                          int rowv[8], dv[8]; unsigned gb[8]; bool okv[8], inr[8];
                          _Pragma("unroll") for (int k = 0; k < 8; ++k) { const int idx = base + k * NTHR + tid; inr[k] = idx < nrows; okv[k] = false; rowv[k] = 0; dv[k] = 0; gb[k] = 0u;
                              if (inr[k]) { const int pm = tl[1 + (idx >> 8)], r = idx & 255, e = mt_e[pm], g = (pm - tab[96 + e]) * 256 + r; rowv[k] = pm * 256 + r;
                                  if (g < tab[64 + e]) { int lo = 0;
                                      _Pragma("unroll") for (int st = 32; st > 0; st >>= 1) { if (pfx[(lo + st) * 32 + e] <= g) lo += st; }
                                      { const u32x2 en_ = tglist[((size_t)lo * 32 + e) * 512 + (g - pfx[lo * 32 + e])]; dv[k] = (int)en_.x; gb[k] = en_.y; } okv[k] = true; } } }
                          float gv[8];
                          _Pragma("unroll") for (int k = 0; k < 8; ++k) gv[k] = okv[k] ? __builtin_bit_cast(float, gb[k]) : 0.f;
                          _Pragma("unroll") for (int k = 0; k < 8; ++k) if (inr[k]) { row_tok[rowv[k]] = okv[k] ? (dv[k] >> 2) : 0; row_dst[rowv[k]] = okv[k] ? dv[k] : -1; row_gate[rowv[k]] = gv[k]; } }
                      VM_WAIT(); __syncthreads(); }
                    pg8::gemm_phase<pg8::EpiMoe1, pg8::MoeSched<true>, true>(lds, DM / 2, S, E);
                    if (cvb) { const int nl = T >= R * Ge ? Ge : T - (R - 1) * Ge; HOST_NOTE(); cv_limit = 2 * CNIT; cv_thr = HOST_THR(2, nl); } }
                } else { if constexpr (HAS(13)) {
                    pg8::MoeSched<false> S; S.A = (const char*)(ws + WS_H); S.B = (const char*)(ws + WS_WD + (size_t)l * NE * DM * DM); S.lda = DM / 2; S.ldb = DM / 2; S.b_es = (size_t)DM * DM; S.nN = 4; S.n_mt = n_mt; S.mt_e = mt_e; S.row_tok = nullptr;
                    const int T = 4 * n_mt, R = (T + G - 1) / G; int kc = 0;
                    if (l == 0 && (G & 7) == 0 && G >= 64) { kc = (((R * G - T) + R - 1) / R + 7) & ~7; kc = kc > 32 ? 32 : kc; }
                    const int Ge = G - kc, Lmain = T < R * Ge ? T : R * Ge; const bool cvb = bid >= Ge;
                    S.G = cvb ? kc : Ge; S.c = cvb ? bid - Ge : bid; S.L0 = cvb ? Lmain : 0; S.Lend = cvb ? T : Lmain;
                    S.note = (l == 0 && !cvb) ? (unsigned long long*)((unsigned*)(ws + WS_CTL) + CQ_WORD) : nullptr;
                    pg8::EpiMoe2 E{(const int*)(ws + WS_ROWDST), (const float*)(ws + WS_ROWGATE), a.in[I_EBD + zq] + (size_t)l * NE * DM, ws + WS_SLAB, PROBE_DRY && probe_rep > 0, lds};
                    pg8::gemm_phase<pg8::EpiMoe2, pg8::MoeSched<false>, true>(lds, DM / 2, S, E);
                    if (cvb) { const int nl = T >= R * Ge ? Ge : T - (R - 1) * Ge; HOST_NOTE(); cv_limit = 2 * CNIT; cv_thr = HOST_THR(3, nl); } }
                }
            } }
        }
        _Pragma("unroll 1") for (int pass = 0; pass < 2; ++pass) {
        if constexpr (HAS(0)) { if (ph == 0 && pass == 1 - ((bid >> 3) & 1)) { __syncthreads(); for (int u = bid; u < NLAYER * 16 * 8; u += G) ssm_stage1(a, zq, u, lds, tid); __syncthreads(); } }
        if (pass == 0) {
        if (cs_end) { int cs0 = cs_lo;
            if (cs_lo < 0) { const unsigned h = __hip_atomic_load((unsigned*)(ws + WS_CTL) + CQ_WORD, __ATOMIC_RELAXED, __HIP_MEMORY_SCOPE_AGENT); cs0 = CONV_P0N + 16 * (int)(h < (unsigned)CNIT ? h : (unsigned)CNIT); }
            __syncthreads(); conv_static(a, zq, cs0, cs_end, cs_w0, cs_nw, (LAS float*)(lds + wave * 16640), lane); }
        if (cv_limit) { __syncthreads(); conv_pull(a, zq, cv_limit, cv_thr, cv_thr != 0u, lds, tid, wave, lane); } } }
#if MK_N_LAUNCHES
        const int pcode = ph == 0 ? 0 : ph == N_PHASES ? 14 : 1 + sp_of(ph);
        const bool again = (pcode == PROBE_CODE) && (!PROBE_L0ONLY || ph <= PH_PER_LAYER) && (probe_rep < PROBE_REPS);
        if (ph + 1 < a.ph_hi || again) xcd_barrier(bar);
        if (again) ++probe_rep; else { probe_rep = 0; ++ph; }
#else
        ++ph;
#endif
    }
}
__global__ void __launch_bounds__(NTHR, 2) mk_final(Args a) {
    const int tid = threadIdx.x, lane = tid & 63, wave = tid >> 6;
    const int zq = 0; xprep(a, zq, 2, blockIdx.x * NWAVES + wave, gridDim.x * NWAVES, lane);
}

typedef void (*kern_t)(Args);
static kern_t phase_kernel(int code) {
    switch (code) {
        case 0: return mk<1u << 0>; case 1: return mk<1u << 1>; case 2: return mk<1u << 2>; case 3: return mk<1u << 3>; case 4: return mk<1u << 4>; case 5: return mk<1u << 5>; case 6: return mk<1u << 6>;
        case 7: return mk<1u << 7>; case 8: return mk<1u << 8>; case 9: return mk<1u << 9>; case 10: return mk<1u << 10>; case 11: return mk<1u << 11>; case 12: return mk<1u << 12>; default: return mk<1u << 13>;
    }
}
static bool set_lds_all() {
#if MK_N_LAUNCHES == 1
    return hipFuncSetAttribute((const void*)mk<0x777fu>, hipFuncAttributeMaxDynamicSharedMemorySize, LDS_BYTES) == hipSuccess;
#endif
    for (int c = 0; c < 14; ++c) if (hipFuncSetAttribute((const void*)phase_kernel(c), hipFuncAttributeMaxDynamicSharedMemorySize, LDS_BYTES) != hipSuccess) return false; return true; }
static void launch_phase(int code, int grid, hipStream_t stream, const Args& a) { hipLaunchKernelGGL(phase_kernel(code), dim3(grid), dim3(NTHR), LDS_BYTES, stream, a); }
extern "C" void kernel_launch(void* const* d_in, const int* in_sizes, int n_in, void* d_out, int out_size, void* d_ws, size_t ws_size, hipStream_t stream) {
    static int grid = 0;
    if (grid == 0) {
        if (n_in != 36 || out_size != NTOK * DM || ws_size < WS_END) { fprintf(stderr, "kernel_launch: unexpected problem (n_in %d out %d ws %zu, need %zu)\n", n_in, out_size, ws_size, (size_t)WS_END); grid = -1; return; }
        int dev = 0, cus = 0;
        if (hipGetDevice(&dev) != hipSuccess || hipDeviceGetAttribute(&cus, hipDeviceAttributeMultiprocessorCount, dev) != hipSuccess) { grid = -1; return; }
        if (!set_lds_all()) { fprintf(stderr, "kernel_launch: hipFuncSetAttribute failed\n"); grid = -1; return; }
        (void)hipGetLastError();
        int per_cu = 0;
#if MK_N_LAUNCHES == 1
        if (hipOccupancyMaxActiveBlocksPerMultiprocessor(&per_cu, (const void*)mk<0x777fu>, NTHR, LDS_BYTES) != hipSuccess || per_cu < 1) { fprintf(stderr, "kernel_launch: the kernel does not fit a CU (occupancy %d)\n", per_cu); grid = -1; return; }
#endif
        grid = cus;
    }
    if (grid < 0) return;
    (void)hipMemsetAsync((char*)d_ws + WS_CTL, 0, CTL_ZERO_BYTES, stream);
    Args a{};
    for (int i = 0; i < 36; ++i) a.in[i] = (const float*)d_in[i];
    a.out = (float*)d_out; a.ws = (unsigned char*)d_ws;
#if MK_N_LAUNCHES == 1
    a.ph_lo = 0; a.ph_hi = N_PHASES + 1;
    void* kargs[] = {(void*)&a};
    hipError_t e = hipLaunchCooperativeKernel((const void*)mk<0x777fu>, dim3(grid), dim3(NTHR), kargs, LDS_BYTES, stream);
    if (e != hipSuccess) fprintf(stderr, "kernel_launch: cooperative launch failed: %s (grid %d)\n", hipGetErrorString(e), grid);
#else
    for (int ph = 0; ph < N_PHASES; ++ph) { a.ph_lo = ph; a.ph_hi = ph + 1; launch_phase(ph == 0 ? 0 : 1 + sp_of(ph), grid, stream, a); }
    a.ph_lo = 0; a.ph_hi = 0;
    hipLaunchKernelGGL(mk_final, dim3(grid), dim3(NTHR), 0, stream, a);
#endif
}
```

```cpp
#include <hip/hip_runtime.h>
#include <hip/hip_bf16.h>
#include <cstdio>
#include <cstdint>
#include <cmath>

#ifndef MK_N_LAUNCHES
#define MK_N_LAUNCHES 1
#endif

#define LAS __attribute__((address_space(3)))
typedef unsigned short bf16_t;
typedef short bf16x8 __attribute__((ext_vector_type(8)));
typedef short s16x4 __attribute__((ext_vector_type(4)));
typedef float f32x2 __attribute__((ext_vector_type(2)));
typedef float f32x4 __attribute__((ext_vector_type(4)));
typedef float f32x16 __attribute__((ext_vector_type(16)));
typedef unsigned u32x2 __attribute__((ext_vector_type(2)));
typedef unsigned u32x4 __attribute__((ext_vector_type(4)));
typedef int i32x4v __attribute__((ext_vector_type(4)));

constexpr int NB = 8, SEQ = 4096, NTOK = NB * SEQ, DM = 1024, NLAYER = 2, INC = 1540;
constexpr int NE = 32, TOPK = 4, NROWS = NTOK * TOPK, CAP = NROWS + NE * 256;
constexpr int NCHUNK = NTOK / 64, KSSM = 1152, MEMLEN = 256, NMEM = NB * MEMLEN;
constexpr float EPS = 1e-6f, LOG2E = 1.4426950408889634f, C2 = 0.125f * 1.4426950408889634f;
constexpr int NWAVES = 8, NTHR = 512;

constexpr size_t MiB = 1u << 20;
constexpr size_t WS_CTL = 0, CTL_ZERO_BYTES = 64 * 1024;
constexpr size_t WS_WIN = 1 * MiB;
constexpr size_t WS_WKV = 7 * MiB;
constexpr size_t WS_WOUT = 9 * MiB;
constexpr size_t WS_WR = 13 * MiB;
constexpr size_t WS_WGLU = 14 * MiB;
constexpr size_t WS_WPOOL = 14 * MiB + 256 * 1024;
constexpr size_t WS_WF = 14 * MiB + 512 * 1024;
constexpr size_t WS_WSSM = 16 * MiB;
constexpr size_t WS_GSSM = 88 * MiB;
constexpr size_t WS_MEMB = 104 * MiB;
constexpr size_t WS_KVRAW = 108 * MiB;
constexpr size_t WS_MK = 112 * MiB;
constexpr size_t WS_MV = 114 * MiB;
constexpr size_t WS_SMALL = 116 * MiB;
constexpr size_t WS_RINV = WS_SMALL;
constexpr size_t WS_RINV2 = WS_RINV + 128 * 1024;
constexpr size_t WS_RINVM = WS_RINV2 + 128 * 1024;
constexpr size_t WS_FLOG = WS_RINVM + 64 * 1024;
constexpr size_t WS_CK = WS_FLOG + 512 * 1024;
constexpr size_t WS_SSQ = WS_CK + 512 * 1024;
constexpr size_t WS_SSQ2 = WS_SSQ + 2 * MiB;
constexpr size_t WS_LOGIT = WS_SSQ2 + 2 * MiB;
constexpr size_t WS_TKIDX = WS_LOGIT + 4 * MiB;
constexpr size_t WS_TKGATE = WS_TKIDX + 512 * 1024;
constexpr size_t WS_TKRANK = WS_TKGATE + 512 * 1024;
constexpr size_t WS_HIST = WS_TKRANK + 512 * 1024;
constexpr size_t WS_ROWTOK = WS_HIST + 64 * 1024;
constexpr size_t WS_ROWDST = WS_ROWTOK + 576 * 1024;
constexpr size_t WS_ROWGATE = WS_ROWDST + 576 * 1024;
constexpr size_t WS_ROWRINV = WS_ROWGATE + 576 * 1024;
static_assert(WS_ROWRINV + 576 * 1024 <= 132 * MiB, "small region");
constexpr size_t WS_XB = 132 * MiB;
constexpr size_t WS_WGU = 196 * MiB;
constexpr size_t WS_WD = 324 * MiB;
constexpr size_t WS_H = 388 * MiB;
constexpr size_t WS_X8 = WS_H + 144 * MiB;
constexpr size_t WS_MTAB = 600 * MiB;
constexpr size_t WS_LOGITP = 604 * MiB;
constexpr size_t WS_TGLIST = 616 * MiB;
constexpr float WSCALE = 64.0f, WUNSCALE = 1.0f / 64.0f;
constexpr float SLAB_SCALE = 16.0f, SLAB_UNSCALE = 1.0f / 16.0f;
constexpr size_t WS_ACT = 660 * MiB;
constexpr size_t WS_UEXT = WS_ACT;
constexpr size_t WS_UB = WS_ACT + 18 * MiB;
constexpr size_t WS_Q = WS_ACT + 34 * MiB;
constexpr size_t WS_K = WS_ACT + 50 * MiB;
constexpr size_t WS_V = WS_ACT + 66 * MiB;
constexpr size_t WS_QM = WS_ACT + 82 * MiB;
constexpr size_t WS_DP = WS_ACT + 98 * MiB;
constexpr size_t WS_Z = WS_ACT + 114 * MiB;
constexpr size_t WS_S = WS_ACT + 130 * MiB;
constexpr size_t WS_MERGED = WS_ACT + 134 * MiB;
constexpr size_t WS_SLAB = WS_ACT;
constexpr size_t WS_END = 916 * MiB;

constexpr int RING_BYTES = 131072;
constexpr int MISC_OFF = 135168;
constexpr int MOE_TAB_OFF = MISC_OFF + 256;
constexpr int GOFF_OFF = MISC_OFF + 2048;
constexpr int BIAS_OFF = MISC_OFF + 10240;
constexpr int GLU_TAB_OFF = MISC_OFF + 2048;
constexpr int LDS_BYTES = 147456;
static_assert(GLU_TAB_OFF + 4096 <= LDS_BYTES, "LDS map");

__device__ __forceinline__ unsigned f2bf(float f) { unsigned u = __builtin_bit_cast(unsigned, f); return (u + 0x7fffu + ((u >> 16) & 1u)) >> 16; }
typedef __bf16 bf16x2_hw __attribute__((ext_vector_type(2)));
__device__ __forceinline__ unsigned pk2(float lo, float hi) { const f32x2 v = {lo, hi}; return __builtin_bit_cast(unsigned, __builtin_convertvector(v, bf16x2_hw)); }
__device__ __forceinline__ float bflo(unsigned w) { return __builtin_bit_cast(float, w << 16); }
__device__ __forceinline__ float bfhi(unsigned w) { return __builtin_bit_cast(float, w & 0xffff0000u); }
__device__ __forceinline__ float wave_sum(float v) {
#pragma unroll
    for (int o = 1; o < 64; o <<= 1) v += __shfl_xor(v, o);
    return v;
}
__device__ __forceinline__ float fast_sigmoid(float x) { return __builtin_amdgcn_rcpf(1.0f + __builtin_amdgcn_exp2f(-x * LOG2E)); }
__device__ __forceinline__ float clamp448(float x) { return fminf(fmaxf(x, -448.0f), 448.0f); }
__device__ __forceinline__ unsigned pk4_fp8(float a, float b, float c, float d) { int w = 0; w = __builtin_amdgcn_cvt_pk_fp8_f32(clamp448(a), clamp448(b), w, false); w = __builtin_amdgcn_cvt_pk_fp8_f32(clamp448(c), clamp448(d), w, true); return (unsigned)w; }
#define LDS_WAIT() asm volatile("s_waitcnt lgkmcnt(0)" ::: "memory")
#define VM_WAIT() asm volatile("s_waitcnt vmcnt(0)" ::: "memory")

struct Args { const float* in[36]; float* out; unsigned char* ws; int ph_lo, ph_hi; };
enum { I_X = 0, I_MEM, I_MIXG, I_WIN, I_LRE, I_LIM, I_LDT, I_BRE, I_BIM, I_CRE, I_CIM, I_SD, I_GLUW, I_GLUB, I_SOUTG, I_POOLW, I_POOLS, I_FFB, I_FQG, I_FKG, I_FOUTG,
       I_MNG, I_MWKV, I_MQG, I_MKG, I_MOUTG, I_WOUT, I_FFNG, I_RW, I_RB, I_EWG, I_EBG, I_EWU, I_EBU, I_EWD, I_EBD };

namespace pg8 {
constexpr int BM = 256, BK = 64, HALF = 128, HTB = HALF * BK * 2, STAGE_BYTES = 8 * HTB, NXCD = 8, WGM = 8;
__device__ __forceinline__ int lds_byte(int r, int c) { const int st = (r >> 4) * 2 + (c >> 5), rr = r & 15, cc = c & 31, ob = rr * 64 + cc * 2; return st * 1024 + (ob ^ (((ob >> 9) & 1) << 5)); }
__device__ __forceinline__ void stage_rc(int b, int& R, int& C) { const int st = b / 1024, sb = b % 1024, swz = sb ^ (((sb >> 9) & 1) << 5); R = (st >> 1) * 16 + swz / 64; C = (st & 1) * 32 + (swz % 64) / 2; }
__device__ __forceinline__ int perm32(int rho) { const int n = rho >> 4, i = rho & 15; return 8 * (i >> 2) + 4 * n + (i & 3); }

struct Unit { int pm, pn, grp; };

__device__ __forceinline__ int xcd_remap(int wgid, int nwg) { const int q = nwg / NXCD, r = nwg % NXCD, xcd = wgid % NXCD, off = wgid / NXCD; return (xcd < r ? xcd * (q + 1) : r * (q + 1) + (xcd - r) * q) + off; }
__device__ __forceinline__ void tile_of(int w, int nM, int nN, int& pm, int& pn) { const int nig = WGM * nN, gid = w / nig, fm = gid * WGM, gsz = (nM - fm) < WGM ? (nM - fm) : WGM; pm = fm + ((w % nig) % gsz); pn = (w % nig) / gsz; }

struct DenseSched {
    static constexpr bool GATHER = false;
    const char* A; const char* B; int lda, ldb; size_t a_gs, b_gs; int nM, nN, tpg, nwg, G, c;
    __device__ __forceinline__ void init(const void* A_, int lda_, size_t a_gs_, const void* B_, int ldb_, size_t b_gs_, int M, int N, int ngroups, int G_, int c_) {
        A = (const char*)A_; B = (const char*)B_; lda = lda_; ldb = ldb_; a_gs = a_gs_; b_gs = b_gs_; nM = M / BM; nN = N / BM; tpg = nM * nN; nwg = tpg * ngroups; G = G_; c = c_; }
    __device__ __forceinline__ bool next(int i, Unit& u) const {
        const long L = (long)i * G + c; if (L >= nwg) return false;
        const int wgid = xcd_remap((int)L, nwg); u.grp = wgid / tpg; tile_of(wgid % tpg, nM, nN, u.pm, u.pn); return true; }
    __device__ __forceinline__ void bases(const Unit& u, const char*& a, const char*& b) const {
        a = A + (size_t)u.grp * a_gs + (size_t)u.pm * BM * lda * 2; b = B + (size_t)u.grp * b_gs + (size_t)u.pn * BM * ldb * 2; }
    __device__ __forceinline__ unsigned row_off(const Unit&, int) const { return 0u; }
    __device__ __forceinline__ void on_last(int) const {}
};
template <bool GATHER_> struct MoeSched {
    static constexpr bool GATHER = GATHER_;
    const char* A; const char* B; int lda, ldb; size_t b_es; int nN, n_mt, G, c, L0, Lend; const LAS unsigned char* mt_e; const int* row_tok; unsigned long long* note; const LAS int* tok0;
    __device__ __forceinline__ bool next(int i, Unit& u) const {
        const int nwg = n_mt * nN; const long L = (long)L0 + (long)i * G + c; if (L >= Lend) return false;
        const int wgid = xcd_remap((int)L, nwg); tile_of(wgid, n_mt, nN, u.pm, u.pn); u.grp = mt_e[u.pm]; return true; }
    __device__ __forceinline__ void bases(const Unit& u, const char*& a, const char*& b) const {
        a = GATHER ? A : A + (size_t)u.pm * BM * lda * 2; b = B + (size_t)u.grp * b_es + (size_t)u.pn * BM * ldb * 2; }
    __device__ __forceinline__ unsigned row_off(const Unit& u, int r) const { return (unsigned)row_tok[u.pm * BM + r] * (unsigned)(lda * 2); }
    __device__ __forceinline__ void on_last(int tid) const { if (note != nullptr && tid == 0) (void)__hip_atomic_fetch_add(note, 1ull << 32, __ATOMIC_RELAXED, __HIP_MEMORY_SCOPE_AGENT); }
};

typedef int i32x4 __attribute__((ext_vector_type(4)));
typedef int i32x8 __attribute__((ext_vector_type(8)));
__device__ __forceinline__ i32x8 cat8(bf16x8 lo, bf16x8 hi) { return __builtin_shufflevector(__builtin_bit_cast(i32x4, lo), __builtin_bit_cast(i32x4, hi), 0, 1, 2, 3, 4, 5, 6, 7); }
template <class T, class = void> struct has_pre { static constexpr bool value = false; };
template <class T> struct has_pre<T, decltype((void)sizeof(typename T::Pre))> { static constexpr bool value = true; };
struct NoPre {};
template <class T, class = void> struct has_top { static constexpr bool value = false; };
template <class T> struct has_top<T, decltype((void)sizeof(char[T::TOP]))> { static constexpr bool value = true; };
__device__ __forceinline__ void bias_dma(LAS unsigned char* lds, const float* src, int wid) { __builtin_amdgcn_global_load_lds((const unsigned*)src, (LAS unsigned*)(lds + BIAS_OFF + wid * 256), 4, 0, 0); }
template <int NY> __device__ __forceinline__ void bias_read(LAS unsigned char* lds, int wid, int fq, f32x4 (&b)[4]) {
    if constexpr (NY >= 0) asm volatile("s_waitcnt vmcnt(%0)" :: "n"(NY) : "memory");
#pragma unroll
    for (int j = 0; j < 4; ++j) b[j] = *(const LAS f32x4*)(lds + BIAS_OFF + wid * 256 + fq * 64 + j * 16);
}
template <class T, class = void> struct emin_of { static constexpr int value = 0; };
template <class T> struct emin_of<T, decltype((void)sizeof(char[T::EMIN]))> { static constexpr int value = T::EMIN; };
template <class T, bool = has_pre<T>::value> struct pre_of { typedef NoPre type; };
template <class T> struct pre_of<T, true> { typedef typename T::Pre type; };
template <class Epi, class Sched, bool FP8 = false>
__device__ __forceinline__ void gemm_phase(LAS unsigned char* lds, const int K, const Sched& S, const Epi& E) {
    int tid = threadIdx.x; asm volatile("" : "+v"(tid));
    const int wid = __builtin_amdgcn_readfirstlane(tid >> 6), lane = tid & 63, wr = wid >> 2, wc = wid & 3, fr = lane & 15, fq = lane >> 4;
    int Kv = K; asm volatile("" : "+s"(Kv));
    const int nt = Kv / BK;
    unsigned voffB[2], cOff[2][2];
#pragma unroll
    for (int i = 0; i < 2; ++i) { int sR, sC; stage_rc(tid * 16 + i * 8192, sR, sC); const int Rb = (int)Epi::PERM == 1 ? ((sR & ~31) + perm32(sR & 31)) : (int)Epi::PERM == 2 ? (64 * (sR >> 5) + 16 * ((sR >> 2) & 3) + 4 * ((sR >> 4) & 1) + (sR & 3)) : sR; voffB[i] = (unsigned)(Rb * S.ldb + sC) * 2u; }
    const size_t kstep = (size_t)(BK * 2);
    const size_t hstepB = (size_t)((int)Epi::PERM == 2 ? 8 : HALF) * S.ldb * 2;
    const unsigned ldsw = (unsigned)wid * 1024u;
    const int aoff = lds_byte(wr * 64 + fr, fq * 8), boff = lds_byte(wc * 32 + fr, fq * 8);
#define PG8_SA(b, h) (((b) * 2 + (h)) * HTB)
#define PG8_SB(b, h) ((4 + (b) * 2 + (h)) * HTB)
#define PG8_STAGE(bufoff, gbase, voff) do { _Pragma("unroll") for (int _i = 0; _i < 2; ++_i) { unsigned _vo = (voff)[_i]; asm volatile("" : "+v"(_vo));     \
        __builtin_amdgcn_global_load_lds((const unsigned*)((const char*)(gbase) + _vo), (LAS unsigned*)(lds + (bufoff) + ldsw + _i * 8192), 16, 0, 0); } } while (0)
#define PG8_AOFF(o, u) do { _Pragma("unroll") for (int _h = 0; _h < 2; ++_h) _Pragma("unroll") for (int _i = 0; _i < 2; ++_i) { int _r, _c; stage_rc(tid * 16 + _i * 8192, _r, _c); \
        if constexpr (Sched::GATHER) o[_h][_i] = S.row_off(u, _h * HALF + _r) + (unsigned)(_c * 2); else o[_h][_i] = (unsigned)((_h * HALF + _r) * S.lda + _c) * 2u; } } while (0)
#define PG8_GOFF(o, h_) do { _Pragma("unroll") for (int _i = 0; _i < 2; ++_i) { int _r, _c; stage_rc(tid * 16 + _i * 8192, _r, _c); \
        o[_i] = *(const LAS unsigned*)(lds + GOFF_OFF + wid * 1024 + ((h_) * 2 + _i) * 256 + lane * 4) * (unsigned)(S.lda * 2) + (unsigned)(_c * 2); } } while (0)
#define PG8_LDA(dst, b, h) do { _Pragma("unroll") for (int m = 0; m < 4; ++m) _Pragma("unroll") for (int k = 0; k < 2; ++k) dst[m][k] = *(const LAS bf16x8*)(lds + PG8_SA(b, h) + aoff + m * 2048 + k * 1024); } while (0)
#define PG8_LDB(dst, b, h) do { _Pragma("unroll") for (int n = 0; n < 2; ++n) _Pragma("unroll") for (int k = 0; k < 2; ++k) dst[n][k] = *(const LAS bf16x8*)(lds + PG8_SB(b, h) + boff + n * 2048 + k * 1024); } while (0)
#define PG8_MMA(ai, bj, At, Bt) do { __builtin_amdgcn_s_setprio(1); _Pragma("unroll") for (int m = 0; m < 4; ++m) _Pragma("unroll") for (int n = 0; n < 2; ++n) { \
        if constexpr (FP8) { asm volatile("v_mfma_scale_f32_16x16x128_f8f6f4 %0, %1, %2, %0, %3, %3 op_sel_hi:[0,0,0]" : "+v"(acc[ai][bj][m][n]) : "v"(cat8(Bt[n][0], Bt[n][1])), "v"(cat8(At[m][0], At[m][1])), "v"(fp8_unit_scale)); } \
        else { _Pragma("unroll") for (int k = 0; k < 2; ++k) acc[ai][bj][m][n] = __builtin_amdgcn_mfma_f32_16x16x32_bf16(Bt[n][k], At[m][k], acc[ai][bj][m][n], 0, 0, 0); } } \
        __builtin_amdgcn_s_setprio(0); } while (0)
#define PG8_WAIT_V(n) asm volatile("s_waitcnt vmcnt(" #n ")" ::: "memory")
#define PG8_WAIT_V8R(rel) do { if (emin_of<Epi>::value > 0 && (rel)) asm volatile("s_waitcnt vmcnt(%0)" :: "n"(8 + emin_of<Epi>::value) : "memory"); else asm volatile("s_waitcnt vmcnt(8)" ::: "memory"); } while (0)
#define PG8_WAIT_L(n) asm volatile("s_waitcnt lgkmcnt(" #n ")" ::: "memory")
#define PG8_BAR __builtin_amdgcn_s_barrier()
#define PG8_SCHED __builtin_amdgcn_sched_barrier(0)
    Unit cur, nxt; int ui = 0;
    if (!S.next(0, cur)) return;
    const int fp8_unit_scale = 0x7f7f7f7f;
    f32x4 acc[2][2][4][2];
    if constexpr (!has_pre<Epi>::value) {
#pragma unroll
    for (int a = 0; a < 2; ++a)
#pragma unroll
        for (int b = 0; b < 2; ++b)
#pragma unroll
            for (int m = 0; m < 4; ++m)
#pragma unroll
                for (int n = 0; n < 2; ++n) acc[a][b][m][n] = (f32x4){0.f, 0.f, 0.f, 0.f}; }
    bf16x8 At[4][2], B0[2][2], B1[2][2];
    const char* cA; const char* cB; S.bases(cur, cA, cB);
    if constexpr (Sched::GATHER) {
        if (S.tok0 != nullptr) {
#pragma unroll
            for (int h = 0; h < 2; ++h)
#pragma unroll
                for (int i = 0; i < 2; ++i) { int r_, c_; stage_rc(tid * 16 + i * 8192, r_, c_); cOff[h][i] = (unsigned)S.tok0[h * HALF + r_] * (unsigned)(S.lda * 2) + (unsigned)(c_ * 2); } }
        else { PG8_AOFF(cOff, cur); } }
    else { PG8_AOFF(cOff, cur); }
    PG8_STAGE(PG8_SB(0, 0), cB, voffB); PG8_STAGE(PG8_SB(0, 1), cB + hstepB, voffB); PG8_STAGE(PG8_SA(0, 0), cA, cOff[0]); PG8_STAGE(PG8_SA(0, 1), cA, cOff[1]);
    if (wr == 1) PG8_BAR;
    PG8_WAIT_V(2); PG8_BAR;
    PG8_STAGE(PG8_SB(1, 0), cB + kstep, voffB); PG8_STAGE(PG8_SA(1, 0), cA + kstep, cOff[0]); PG8_STAGE(PG8_SB(1, 1), cB + hstepB + kstep, voffB);
    PG8_WAIT_V(6); PG8_BAR;
    if constexpr (has_pre<Epi>::value) { E.pre_load(lds, cur, wid, wc, fr, fq); E.template pre_apply<0>(acc, lds, wid, fq); }
    for (;;) {
        const bool has_next = S.next(ui + 1, nxt);
        if (!has_next) S.on_last(tid);
        const char* nA = cA; const char* nB = cB;
        if (has_next) S.bases(nxt, nA, nB);
        if constexpr (has_pre<Epi>::value) { E.pre_load(lds, has_next ? nxt : cur, wid, wc, fr, fq); E.unit_top(lds, cur, wid, wr, lane); }
        else if constexpr (has_top<Epi>::value) E.unit_top(lds, cur, wid, wr, lane);
        if constexpr (Sched::GATHER) { {
#pragma unroll
            for (int h = 0; h < 2; ++h)
#pragma unroll
                for (int i = 0; i < 2; ++i) { int r_, c_; stage_rc(tid * 16 + i * 8192, r_, c_);
                    __builtin_amdgcn_global_load_lds((const unsigned*)(S.row_tok + (has_next ? nxt.pm : cur.pm) * BM + h * HALF + r_), (LAS unsigned*)(lds + GOFF_OFF + wid * 1024 + (h * 2 + i) * 256), 4, 0, 0); } } }
        for (int t = 0; t < nt; t += 2) {
            const bool last = (t == nt - 2);
            const char* a1 = cA + (size_t)(t + 1) * kstep;
            const char* a2 = last ? nA : cA + (size_t)(t + 2) * kstep; const char* b2 = last ? nB : cB + (size_t)(t + 2) * kstep;
            const char* a3 = a2 + kstep; const char* b3 = b2 + kstep;
            unsigned o20[2], o21[2];
#pragma unroll
            for (int i = 0; i < 2; ++i) { o20[i] = cOff[0][i]; o21[i] = cOff[1][i]; }
            if constexpr (Sched::GATHER) { if (last) { PG8_GOFF(o20, 0); PG8_GOFF(o21, 1); } }
            const bool relax = (t == 0) && (ui > 0);
            PG8_LDB(B0, 0, 0); PG8_LDB(B1, 0, 1); PG8_SCHED; PG8_LDA(At, 0, 0); PG8_STAGE(PG8_SA(1, 1), a1, cOff[1]);
            PG8_WAIT_V8R(relax); PG8_WAIT_L(0); PG8_BAR; PG8_MMA(0, 0, At, B0); PG8_MMA(0, 1, At, B1); PG8_BAR; PG8_SCHED;
            PG8_LDA(At, 0, 1); PG8_STAGE(PG8_SB(0, 0), b2, voffB); PG8_STAGE(PG8_SB(0, 1), b2 + hstepB, voffB); PG8_STAGE(PG8_SA(0, 0), a2, o20);
            PG8_WAIT_V8R(relax); PG8_WAIT_L(0); PG8_BAR; PG8_MMA(1, 0, At, B0); PG8_MMA(1, 1, At, B1); PG8_BAR; PG8_SCHED;
            PG8_LDB(B0, 1, 0); PG8_LDB(B1, 1, 1); PG8_SCHED; PG8_LDA(At, 1, 0); PG8_STAGE(PG8_SA(0, 1), a2, o21);
            PG8_WAIT_V(8); PG8_WAIT_L(0); PG8_BAR; PG8_MMA(0, 0, At, B0); PG8_MMA(0, 1, At, B1); PG8_BAR; PG8_SCHED;
            PG8_LDA(At, 1, 1); PG8_STAGE(PG8_SB(1, 0), b3, voffB); PG8_STAGE(PG8_SB(1, 1), b3 + hstepB, voffB); PG8_STAGE(PG8_SA(1, 0), a3, o20);
            PG8_WAIT_V(8); PG8_WAIT_L(0); PG8_BAR; PG8_MMA(1, 0, At, B0); PG8_MMA(1, 1, At, B1); PG8_BAR; PG8_SCHED;
        }
        if (wr == 0) PG8_BAR;
        if constexpr (FP8) asm volatile("s_nop 15\n\ts_nop 15" ::: "memory");
        E(acc, cur, wr, wc, fr, fq);
        if (!has_next) break;
        if constexpr (has_pre<Epi>::value) E.template pre_apply<-1>(acc, lds, wid, fq);
        else {
#pragma unroll
        for (int a = 0; a < 2; ++a)
#pragma unroll
            for (int b = 0; b < 2; ++b)
#pragma unroll
                for (int m = 0; m < 4; ++m)
#pragma unroll
                    for (int n = 0; n < 2; ++n) acc[a][b][m][n] = (f32x4){0.f, 0.f, 0.f, 0.f}; }
        cur = nxt; cA = nA; cB = nB; ++ui;
#pragma unroll
        for (int h = 0; h < 2; ++h)
#pragma unroll
            for (int i = 0; i < 2; ++i) cOff[h][i] = cOff[h][i];
        if constexpr (Sched::GATHER) { PG8_GOFF(cOff[0], 0); PG8_GOFF(cOff[1], 1); }
        if (wr == 1) PG8_BAR;
    }
    PG8_WAIT_V(0);
    PG8_BAR;
#undef PG8_SA
#undef PG8_SB
#undef PG8_STAGE
#undef PG8_AOFF
#undef PG8_LDA
#undef PG8_LDB
#undef PG8_MMA
#undef PG8_WAIT_V
#undef PG8_WAIT_L
#undef PG8_BAR
#undef PG8_SCHED
}
typedef const f32x4 (&AccRef)[2][2][4][2];
typedef f32x4 (&AccMut)[2][2][4][2];

__device__ __forceinline__ u32x4 pack8(f32x4 v0, f32x4 v1) { u32x4 w; w.x = pk2(v0[0], v0[1]); w.y = pk2(v0[2], v0[3]); w.z = pk2(v1[0], v1[1]); w.w = pk2(v1[2], v1[3]); return w; }

#define ROW_OF(ai, m) (u.pm * BM + (ai) * HALF + wr * 64 + (m) * 16 + fr)
struct EpiInProj {
    static constexpr bool PERM = true; const float* rinv; unsigned char* ws; LAS unsigned char* ldsb;
    static constexpr int TOP = 1;
    __device__ __forceinline__ void unit_top(LAS unsigned char* lds, const Unit& u, int wid, int wr, int lane) const {
#pragma unroll
        for (int k = 0; k < 2; ++k) __builtin_amdgcn_global_load_lds((const unsigned*)(rinv + u.pm * BM + 128 * k + 64 * wr + lane), (LAS unsigned*)(lds + GOFF_OFF + wid * 1024 + k * 256), 4, 0, 0); }
    __device__ __forceinline__ void operator()(AccRef acc, const Unit& u, int wr, int wc, int fr, int fq) const {
        asm volatile("" : "+v"(fr), "+v"(fq));
        float rs[8];
#pragma unroll
        for (int q = 0; q < 8; ++q) rs[q] = *(const LAS float*)(ldsb + GOFF_OFF + (wr * 4 + wc) * 1024 + (q >> 2) * 256 + (q & 3) * 64 + fr * 4);
#pragma unroll
        for (int ai = 0; ai < 2; ++ai)
#pragma unroll
            for (int m = 0; m < 4; ++m) { const int row = ROW_OF(ai, m); const float r1 = rs[ai * 4 + m];
#pragma unroll
                for (int bj = 0; bj < 2; ++bj) { const int col = bj * HALF + wc * 32 + 8 * fq; const u32x4 w = pack8(acc[ai][bj][m][0] * r1, acc[ai][bj][m][1] * r1);
                    bf16_t* dst;
                    if (u.pn == 0) dst = (bf16_t*)(ws + WS_UEXT) + ((size_t)((col >> 4) * NCHUNK + (row >> 6)) * KSSM + (row & 63) * 16 + (col & 15));
                    else dst = (bf16_t*)(ws + WS_UB + (size_t)(u.pn - 1) * 16 * MiB) + (size_t)row * 256 + col;
                    *(u32x4*)dst = w; } }
    }
};
struct EpiKv {
    static constexpr bool PERM = true; const float* rinv; bf16_t* out;
    __device__ __forceinline__ void operator()(AccRef acc, const Unit& u, int wr, int wc, int fr, int fq) const {
        asm volatile("" : "+v"(fr), "+v"(fq));
        float rs[8];
#pragma unroll
        for (int q = 0; q < 8; ++q) rs[q] = rinv[ROW_OF(q >> 2, q & 3)];
#pragma unroll
        for (int ai = 0; ai < 2; ++ai)
#pragma unroll
            for (int m = 0; m < 4; ++m) { const int row = ROW_OF(ai, m); const float r1 = rs[ai * 4 + m];
#pragma unroll
                for (int bj = 0; bj < 2; ++bj) { const int col = u.pn * BM + bj * HALF + wc * 32 + 8 * fq;
                    *(u32x4*)(out + ((size_t)u.grp * NMEM + row) * 512 + col) = pack8(acc[ai][bj][m][0] * r1, acc[ai][bj][m][1] * r1); } }
    }
};
struct EpiS {
    static constexpr bool PERM = false; float* out;
    __device__ __forceinline__ void operator()(AccRef acc, const Unit& u, int wr, int wc, int fr, int fq) const {
        asm volatile("" : "+v"(fr), "+v"(fq));
#pragma unroll
        for (int ai = 0; ai < 2; ++ai)
#pragma unroll
            for (int m = 0; m < 4; ++m) { const int row = ROW_OF(ai, m);
#pragma unroll
                for (int n = 0; n < 2; ++n) { const int col = wc * 32 + 16 * n + 4 * fq;
                    *(f32x4*)(out + ((size_t)u.grp * NCHUNK + row) * 128 + col) = acc[ai][0][m][n]; } }
    }
};
__device__ __forceinline__ float gelu_tanh(float y) {
    const float u2 = 1.5957691216057308f * (y + 0.044715f * y * y * y);
    return y * __builtin_amdgcn_rcpf(1.0f + __builtin_amdgcn_exp2f(-u2 * LOG2E));
}
struct EpiY {
    static constexpr bool PERM = true; bf16_t* z;
    __device__ __forceinline__ void operator()(AccRef acc, const Unit& u, int wr, int wc, int fr, int fq) const {
        asm volatile("" : "+v"(fr), "+v"(fq));
#pragma unroll
        for (int ai = 0; ai < 2; ++ai)
#pragma unroll
            for (int m = 0; m < 4; ++m) { const int row = ROW_OF(ai, m);
#pragma unroll
                for (int bj = 0; bj < 2; ++bj) { const int col = u.pn * BM + bj * HALF + wc * 32 + 8 * fq; f32x4 v0 = acc[ai][bj][m][0], v1 = acc[ai][bj][m][1];
#pragma unroll
                    for (int i = 0; i < 4; ++i) { v0[i] = gelu_tanh(v0[i]); v1[i] = gelu_tanh(v1[i]); }
                    *(u32x4*)(z + ((size_t)row * 64 + (col >> 4)) * 256 + u.grp * 16 + (col & 15)) = pack8(v0, v1); } }
    }
};
struct EpiGlu {
    static constexpr int PERM = 1; const bf16_t* z; const float* bias; bf16_t* merged; LAS float* part;
    __device__ __forceinline__ void operator()(AccRef acc, const Unit& u, int wr, int wc, int fr, int fq) const {
        asm volatile("" : "+v"(fr), "+v"(fq));
        f32x4 bb[2][2]; f32x4 o[2][4][2][2];
#pragma unroll
        for (int bj = 0; bj < 2; ++bj) { const int col = bj * HALF + wc * 32 + 8 * fq; bb[bj][0] = *(const f32x4*)(bias + col); bb[bj][1] = *(const f32x4*)(bias + col + 4); }
#pragma unroll
        for (int ai = 0; ai < 2; ++ai) {
            u32x4 zz[4][2];
#pragma unroll
            for (int m = 0; m < 4; ++m)
#pragma unroll
                for (int bj = 0; bj < 2; ++bj) zz[m][bj] = *(const u32x4*)(z + (size_t)ROW_OF(ai, m) * 256 + bj * HALF + wc * 32 + 8 * fq);
#pragma unroll
            for (int m = 0; m < 4; ++m) { float s = 0.f;
#pragma unroll
                for (int bj = 0; bj < 2; ++bj) { const u32x4 zq_ = zz[m][bj];
                    const f32x4 z0 = {bflo(zq_.x), bfhi(zq_.x), bflo(zq_.y), bfhi(zq_.y)}, z1 = {bflo(zq_.z), bfhi(zq_.z), bflo(zq_.w), bfhi(zq_.w)};
                    f32x4 v0 = acc[ai][bj][m][0] + bb[bj][0], v1 = acc[ai][bj][m][1] + bb[bj][1];
#pragma unroll
                    for (int i = 0; i < 4; ++i) { v0[i] = z0[i] * fast_sigmoid(v0[i]); v1[i] = z1[i] * fast_sigmoid(v1[i]); s += v0[i] * v0[i] + v1[i] * v1[i]; }
                    o[ai][m][bj][0] = v0; o[ai][m][bj][1] = v1; }
                s += __shfl_xor(s, 16); s += __shfl_xor(s, 32);
                if (fq == 0) part[(ai * HALF + wr * 64 + m * 16 + fr) * 4 + wc] = s; } }
        asm volatile("s_waitcnt lgkmcnt(0)" ::: "memory"); __builtin_amdgcn_s_barrier(); asm volatile("" ::: "memory");
#pragma unroll
        for (int ai = 0; ai < 2; ++ai)
#pragma unroll
            for (int m = 0; m < 4; ++m) { const f32x4 p4 = *(const LAS f32x4*)(part + (ai * HALF + wr * 64 + m * 16 + fr) * 4);
                const float rs = 1.0f / sqrtf(((p4[0] + p4[1]) + (p4[2] + p4[3])) * (1.0f / 256.0f) + EPS);
#pragma unroll
                for (int bj = 0; bj < 2; ++bj) *(u32x4*)(merged + (size_t)ROW_OF(ai, m) * DM + bj * HALF + wc * 32 + 8 * fq) = pack8(o[ai][m][bj][0] * rs, o[ai][m][bj][1] * rs); }
        asm volatile("s_waitcnt lgkmcnt(0)" ::: "memory"); __builtin_amdgcn_s_barrier(); asm volatile("" ::: "memory");
    }
};
struct EpiPool {
    static constexpr bool PERM = true; bf16_t* merged; float* ssq;
    __device__ __forceinline__ void operator()(AccRef acc, const Unit& u, int wr, int wc, int fr, int fq) const {
        asm volatile("" : "+v"(fr), "+v"(fq));
#pragma unroll
        for (int ai = 0; ai < 2; ++ai)
#pragma unroll
            for (int m = 0; m < 4; ++m) { const int row = ROW_OF(ai, m); float s = 0.f;
#pragma unroll
                for (int bj = 0; bj < 2; ++bj) { const int col = bj * HALF + wc * 32 + 8 * fq; const f32x4 v0 = acc[ai][bj][m][0], v1 = acc[ai][bj][m][1];
#pragma unroll
                    for (int i = 0; i < 4; ++i) s += v0[i] * v0[i] + v1[i] * v1[i];
                    *(u32x4*)(merged + (size_t)row * DM + 256 + col) = pack8(v0, v1); }
                s += __shfl_xor(s, 16); s += __shfl_xor(s, 32);
                if (fq == 0) ssq[(size_t)row * 16 + 4 + wc] = s; }
    }
};
struct EpiWout {
    static constexpr bool PERM = false; bf16_t* xb; float* ssq2;
    __device__ __forceinline__ void operator()(AccRef acc, const Unit& u, int wr, int wc, int fr, int fq) const {
        asm volatile("" : "+v"(fr), "+v"(fq));
#pragma unroll
        for (int ai = 0; ai < 2; ++ai) {
            u32x2 xo[4][2][2];
#pragma unroll
            for (int m = 0; m < 4; ++m)
#pragma unroll
                for (int bj = 0; bj < 2; ++bj)
#pragma unroll
                    for (int n = 0; n < 2; ++n) xo[m][bj][n] = *(const u32x2*)(xb + (size_t)ROW_OF(ai, m) * DM + u.pn * BM + bj * HALF + wc * 32 + 16 * n + 4 * fq);
#pragma unroll
            for (int m = 0; m < 4; ++m) { const int row = ROW_OF(ai, m); float s = 0.f;
#pragma unroll
                for (int bj = 0; bj < 2; ++bj)
#pragma unroll
                    for (int n = 0; n < 2; ++n) { const size_t off = (size_t)row * DM + u.pn * BM + bj * HALF + wc * 32 + 16 * n + 4 * fq; const u32x2 w0 = xo[m][bj][n];
                        const f32x4 xn = (f32x4){bflo(w0.x), bfhi(w0.x), bflo(w0.y), bfhi(w0.y)} + acc[ai][bj][m][n];
                        u32x2 w; w.x = pk2(xn[0], xn[1]); w.y = pk2(xn[2], xn[3]); *(u32x2*)(xb + off) = w;
                        s += (xn[0] * xn[0] + xn[1] * xn[1]) + (xn[2] * xn[2] + xn[3] * xn[3]); }
                s += __shfl_xor(s, 16); s += __shfl_xor(s, 32);
                if (fq == 0) ssq2[(size_t)row * 16 + u.pn * 4 + wc] = s; } }
    }
};
struct EpiRouter {
    static constexpr bool PERM = false; float* part;
    __device__ __forceinline__ void operator()(AccRef acc, const Unit& u, int wr, int wc, int fr, int fq) const {
        if (wc != 0) return;
        asm volatile("" : "+v"(fr), "+v"(fq));
#pragma unroll
        for (int ai = 0; ai < 2; ++ai)
#pragma unroll
            for (int m = 0; m < 4; ++m) { float* p = part + ((size_t)u.grp * NTOK + ROW_OF(ai, m)) * 32 + 4 * fq;
                *(f32x4*)p = acc[ai][0][m][0]; *(f32x4*)(p + 16) = acc[ai][0][m][1]; }
    }
};
struct EpiMoe1 {
    static constexpr bool PERM = true; const float* bg; const float* bu; unsigned char* h; int dry;
    struct Pre {};
    static constexpr int EMIN = 12;
    __device__ __forceinline__ void unit_top(LAS unsigned char*, const Unit&, int, int, int) const {}
    __device__ __forceinline__ void pre_load(LAS unsigned char* lds, const Unit& u, int wid, int wc, int fr, int fq) const { const size_t o = (size_t)u.grp * DM + u.pn * HALF + wc * 32 + 8 * fq;
        bias_dma(lds, (fr < 8 ? bg : bu - 8) + o + fr, wid); }
    template <int NY> __device__ __forceinline__ void pre_apply(AccMut acc, LAS unsigned char* lds, int wid, int fq) const { f32x4 b[4]; bias_read<NY>(lds, wid, fq, b);
#pragma unroll
        for (int ai = 0; ai < 2; ++ai)
#pragma unroll
            for (int m = 0; m < 4; ++m)
#pragma unroll
                for (int n = 0; n < 2; ++n) { acc[ai][0][m][n] = b[n] * WSCALE; acc[ai][1][m][n] = b[2 + n] * WSCALE; } }
    __device__ __forceinline__ void operator()(AccRef acc, const Unit& u, int wr, int wc, int fr, int fq) const {
        asm volatile("" : "+v"(fr), "+v"(fq));
        if (dry) { _Pragma("unroll") for (int ai = 0; ai < 2; ++ai) _Pragma("unroll") for (int bj = 0; bj < 2; ++bj) _Pragma("unroll") for (int m = 0; m < 4; ++m) _Pragma("unroll") for (int n = 0; n < 2; ++n) asm volatile("" :: "v"(acc[ai][bj][m][n])); asm volatile("s_waitcnt vmcnt(0)" ::: "memory"); return; }
        const int hid = u.pn * HALF + wc * 32 + 8 * fq;
        const float c1 = -1.702f * LOG2E * WUNSCALE;
#pragma unroll
        for (int ai = 0; ai < 2; ++ai)
#pragma unroll
            for (int m = 0; m < 4; ++m) { const int row = ROW_OF(ai, m); f32x2 hv[4];
#pragma unroll
                for (int q = 0; q < 4; ++q) { const f32x4 ag = acc[ai][0][m][q >> 1], au = acc[ai][1][m][q >> 1];
                    f32x2 G = (f32x2){ag[2 * (q & 1)], ag[2 * (q & 1) + 1]}, U = (f32x2){au[2 * (q & 1)], au[2 * (q & 1) + 1]};
                    G[0] = __builtin_amdgcn_fmed3f(G[0], -3.0e38f, 448.0f); G[1] = __builtin_amdgcn_fmed3f(G[1], -3.0e38f, 448.0f);
                    U[0] = __builtin_amdgcn_fmed3f(U[0], -448.0f, 448.0f); U[1] = __builtin_amdgcn_fmed3f(U[1], -448.0f, 448.0f);
                    const f32x2 t = G * c1 + 12.0f; const f32x2 d = (f32x2){__builtin_amdgcn_exp2f(t[0]), __builtin_amdgcn_exp2f(t[1])} + 4096.0f;
                    const f32x2 r = {__builtin_amdgcn_rcpf(d[0]), __builtin_amdgcn_rcpf(d[1])};
                    hv[q] = ((U + 64.0f) * G) * r; }
                u32x2 w; int w0 = 0, w1 = 0;
                w0 = __builtin_amdgcn_cvt_pk_fp8_f32(hv[0][0], hv[0][1], w0, false); w0 = __builtin_amdgcn_cvt_pk_fp8_f32(hv[1][0], hv[1][1], w0, true);
                w1 = __builtin_amdgcn_cvt_pk_fp8_f32(hv[2][0], hv[2][1], w1, false); w1 = __builtin_amdgcn_cvt_pk_fp8_f32(hv[3][0], hv[3][1], w1, true);
                w.x = (unsigned)w0; w.y = (unsigned)w1;
                *(u32x2*)(h + (size_t)row * DM + hid) = w; }
    }
};
struct EpiMoe2 {
    static constexpr int PERM = 2; const int* row_dst; const float* row_gate; const float* bd; unsigned char* slab; int dry;
    struct Pre {};
    static constexpr int EMIN = 5;
    __device__ __forceinline__ void unit_top(LAS unsigned char* lds, const Unit& u, int wid, int wr, int lane) const {
#pragma unroll
        for (int k = 0; k < 2; ++k) { const int row = u.pm * BM + 128 * k + 64 * wr + lane;
            __builtin_amdgcn_global_load_lds((const unsigned*)(row_dst + row), (LAS unsigned*)(lds + GOFF_OFF + wid * 1024 + k * 256), 4, 0, 0);
            __builtin_amdgcn_global_load_lds((const unsigned*)(row_gate + row), (LAS unsigned*)(lds + GOFF_OFF + wid * 1024 + (2 + k) * 256), 4, 0, 0); } }
    LAS unsigned char* ldsb;
    __device__ __forceinline__ void pre_load(LAS unsigned char* lds, const Unit& u, int wid, int wc, int fr, int fq) const { bias_dma(lds, bd + (size_t)u.grp * DM + u.pn * BM + wc * 64 + 16 * fq + fr, wid); }
    template <int NY> __device__ __forceinline__ void pre_apply(AccMut acc, LAS unsigned char* lds, int wid, int fq) const { f32x4 b[4]; bias_read<NY>(lds, wid, fq, b);
#pragma unroll
        for (int ai = 0; ai < 2; ++ai)
#pragma unroll
            for (int bj = 0; bj < 2; ++bj)
#pragma unroll
                for (int m = 0; m < 4; ++m)
#pragma unroll
                    for (int n = 0; n < 2; ++n) acc[ai][bj][m][n] = b[2 * bj + n] * WSCALE; }
    __device__ __forceinline__ void operator()(AccRef acc, const Unit& u, int wr, int wc, int fr, int fq) const {
        asm volatile("" : "+v"(fr), "+v"(fq));
        if (dry == 1) { _Pragma("unroll") for (int ai = 0; ai < 2; ++ai) _Pragma("unroll") for (int bj = 0; bj < 2; ++bj) _Pragma("unroll") for (int m = 0; m < 4; ++m) _Pragma("unroll") for (int n = 0; n < 2; ++n) asm volatile("" :: "v"(acc[ai][bj][m][n])); return; }
        const int c0 = u.pn * BM + wc * 64 + 16 * fq;
        int dsts[8]; float gts[8];
#pragma unroll
        for (int q = 0; q < 8; ++q) { const LAS unsigned char* sl = ldsb + GOFF_OFF + (wr * 4 + wc) * 1024 + (q >> 2) * 256 + (q & 3) * 64 + fr * 4;
            dsts[q] = *(const LAS int*)sl; gts[q] = *(const LAS float*)(sl + 512) * (SLAB_SCALE * WUNSCALE); }
#pragma unroll
        for (int ai = 0; ai < 2; ++ai)
#pragma unroll
            for (int m = 0; m < 4; ++m) { const int dst = dsts[ai * 4 + m]; const float g = gts[ai * 4 + m];
                if (dst >= 0) { u32x4 w;
#pragma unroll
                    for (int bj = 0; bj < 2; ++bj)
#pragma unroll
                        for (int n = 0; n < 2; ++n) { const f32x4 v = acc[ai][bj][m][n] * g; w[2 * bj + n] = pk4_fp8(v[0], v[1], v[2], v[3]); }
                    *(u32x4*)(slab + (size_t)dst * DM + c0) = w; } }
    }
};
#undef ROW_OF
}

namespace att {
constexpr int LDS_K = 0, LDS_V = 8192, LDS_CK = 16384, LDS_WS = 16640, LDS_OST = 18688, LDS_BYTES_ = LDS_OST + 8 * 4096;
__device__ __forceinline__ int crow(int r, int hi) { return (r & 3) + 8 * (r >> 2) + 4 * hi; }
typedef short v4i16_t __attribute__((ext_vector_type(4)));
__device__ __forceinline__ s16x4 vtr(const LAS unsigned char* p) { return __builtin_bit_cast(s16x4, __builtin_amdgcn_ds_read_tr16_b64_v4i16((LAS v4i16_t*)p)); }
typedef __bf16 bf16x2_t __attribute__((ext_vector_type(2)));
__device__ __forceinline__ unsigned cvtpk(float lo, float hi) { f32x2 v = {lo, hi}; bf16x2_t b = __builtin_convertvector(v, bf16x2_t); return __builtin_bit_cast(unsigned, b); }

__device__ __forceinline__ void unit(LAS unsigned char* shm, const bf16_t* Q, size_t qrow0, const bf16_t* K, const bf16_t* V, size_t kvrow0, int hcol, const float* ck, int NT, bool causal,
                                     bf16_t* obase, float* ssq) {
    int tid = threadIdx.x; asm volatile("" : "+v"(tid));
    const int lane = tid & 63, r32 = lane & 31, hi = lane >> 5; const int wid = __builtin_amdgcn_readfirstlane(tid >> 6);
    const bf16_t* Qw = Q + (qrow0 + wid * 32 + r32) * 256 + hcol;
    bf16x8 qr[4];
#pragma unroll
    for (int d0 = 0; d0 < 4; ++d0) qr[d0] = *(const bf16x8*)(Qw + d0 * 16 + hi * 8);
    float m_run = -INFINITY, l_run = 0.f; f32x16 o[2];
#pragma unroll
    for (int r = 0; r < 16; ++r) { o[0][r] = 0.f; o[1][r] = 0.f; }
    LAS float* wsf = (LAS float*)(shm + LDS_WS) + wid * 64;
    const LAS float* cks = (const LAS float*)(shm + LDS_CK);
    const LAS unsigned char* kb = shm + LDS_K + hi * 1024 + r32 * 16;
    const LAS unsigned char* vp = shm + LDS_V + ((lane >> 4) & 1) * 32 + (lane & 3) * 8 + (4 * hi + ((lane & 15) >> 2)) * 64;
    const int qrel = wid * 32 + r32;
    const bf16_t* ksrc = K + (kvrow0 + lane) * 256 + hcol + wid * 8;
    const bf16_t* vsrc = V + (kvrow0 + 16 * (wid & 3) + (lane >> 2)) * 256 + hcol + (wid >> 2) * 32 + (lane & 3) * 8;
    u32x4 kreg = *(const u32x4*)ksrc, vreg = *(const u32x4*)vsrc;
    for (int t = 0; t < NT; ++t) {
        __syncthreads();
        *(LAS u32x4*)(shm + LDS_K + wid * 1024 + lane * 16) = kreg;
        *(LAS u32x4*)(shm + LDS_V + wid * 1024 + lane * 16) = vreg;
        if (ck != nullptr && tid < 64) ((LAS float*)(shm + LDS_CK))[tid] = ck[t * 64 + tid];
        __syncthreads();
        if (t + 1 < NT) { kreg = *(const u32x4*)(ksrc + (size_t)(t + 1) * 64 * 256); vreg = *(const u32x4*)(vsrc + (size_t)(t + 1) * 64 * 256); }
        f32x16 p0, p1;
#pragma unroll
        for (int r = 0; r < 16; ++r) { p0[r] = 0.f; p1[r] = 0.f; }
#pragma unroll
        for (int d0 = 0; d0 < 4; ++d0) {
            const bf16x8 b0 = *(const LAS bf16x8*)(kb + d0 * 2048), b1 = *(const LAS bf16x8*)(kb + d0 * 2048 + 512);
            p0 = __builtin_amdgcn_mfma_f32_32x32x16_bf16(b0, qr[d0], p0, 0, 0, 0); p1 = __builtin_amdgcn_mfma_f32_32x32x16_bf16(b1, qr[d0], p1, 0, 0, 0); }
        if (ck != nullptr) {
#pragma unroll
            for (int r = 0; r < 16; ++r) { p0[r] -= cks[crow(r, hi)]; p1[r] -= cks[32 + crow(r, hi)]; } }
        if (causal && t >= NT - 4) { const int kb0 = 64 * (t - (NT - 4)) + 4 * hi;
#pragma unroll
            for (int r = 0; r < 16; ++r) { const int kv = kb0 + (r & 3) + 8 * (r >> 2); if (kv > qrel) p0[r] = -INFINITY; if (kv + 32 > qrel) p1[r] = -INFINITY; } }
        float rm = fmaxf(p0[0], p1[0]);
#pragma unroll
        for (int r = 1; r < 16; ++r) rm = fmaxf(rm, fmaxf(p0[r], p1[r]));
        rm = fmaxf(rm, __shfl_xor(rm, 32));
        const float mn = fmaxf(m_run, rm); const float alpha = __builtin_amdgcn_exp2f(m_run - mn); m_run = mn;
        float ls = 0.f;
#pragma unroll
        for (int r = 0; r < 16; ++r) { p0[r] = __builtin_amdgcn_exp2f(p0[r] - mn); p1[r] = __builtin_amdgcn_exp2f(p1[r] - mn); ls += p0[r] + p1[r]; }
        l_run = l_run * alpha + ls;
        if (hi == 0) wsf[r32] = alpha;
        LDS_WAIT();
#pragma unroll
        for (int r = 0; r < 16; ++r) { const float f = wsf[crow(r, hi)]; o[0][r] *= f; o[1][r] *= f; }
        bf16x8 pa[4];
        { u32x4 w;
          w.x = cvtpk(p0[0], p0[1]); w.y = cvtpk(p0[2], p0[3]); w.z = cvtpk(p0[4], p0[5]); w.w = cvtpk(p0[6], p0[7]); pa[0] = __builtin_bit_cast(bf16x8, w);
          w.x = cvtpk(p0[8], p0[9]); w.y = cvtpk(p0[10], p0[11]); w.z = cvtpk(p0[12], p0[13]); w.w = cvtpk(p0[14], p0[15]); pa[1] = __builtin_bit_cast(bf16x8, w);
          w.x = cvtpk(p1[0], p1[1]); w.y = cvtpk(p1[2], p1[3]); w.z = cvtpk(p1[4], p1[5]); w.w = cvtpk(p1[6], p1[7]); pa[2] = __builtin_bit_cast(bf16x8, w);
          w.x = cvtpk(p1[8], p1[9]); w.y = cvtpk(p1[10], p1[11]); w.z = cvtpk(p1[12], p1[13]); w.w = cvtpk(p1[14], p1[15]); pa[3] = __builtin_bit_cast(bf16x8, w); }
#pragma unroll
        for (int d0 = 0; d0 < 2; ++d0)
#pragma unroll
            for (int ks = 0; ks < 4; ++ks) { const s16x4 lo = vtr(vp + d0 * 4096 + ks * 1024), hh = vtr(vp + d0 * 4096 + ks * 1024 + 512);
                const bf16x8 vb = {lo[0], lo[1], lo[2], lo[3], hh[0], hh[1], hh[2], hh[3]};
                o[d0] = __builtin_amdgcn_mfma_f32_32x32x16_bf16(pa[ks], vb, o[d0], 0, 0, 0); }
    }
    l_run += __shfl_xor(l_run, 32);
    if (hi == 0) wsf[32 + r32] = l_run;
    LDS_WAIT();
    LAS bf16_t* stg = (LAS bf16_t*)(shm + LDS_OST) + wid * 2048;
#pragma unroll
    for (int r = 0; r < 16; ++r) { const int orow = crow(r, hi); const float rl = __builtin_amdgcn_rcpf(wsf[32 + orow]);
        stg[orow * 64 + r32] = (bf16_t)f2bf(o[0][r] * rl); stg[orow * 64 + 32 + r32] = (bf16_t)f2bf(o[1][r] * rl); }
    LDS_WAIT();
#pragma unroll
    for (int i = 0; i < 4; ++i) { const int row = i * 8 + (lane >> 3), ch = lane & 7; const u32x4 v = *(const LAS u32x4*)(stg + row * 64 + ch * 8);
        const size_t grow = qrow0 + wid * 32 + row;
        *(u32x4*)(obase + grow * DM + ch * 8) = v;
        float s = bflo(v.x) * bflo(v.x) + bfhi(v.x) * bfhi(v.x) + bflo(v.y) * bflo(v.y) + bfhi(v.y) * bfhi(v.y) + bflo(v.z) * bflo(v.z) + bfhi(v.z) * bfhi(v.z) + bflo(v.w) * bflo(v.w) + bfhi(v.w) * bfhi(v.w);
        s += __shfl_xor(s, 1); s += __shfl_xor(s, 2); s += __shfl_xor(s, 4);
        if (ch == 0) ssq[grow * 16] = s; }
    LDS_WAIT();
}
}

namespace attn_body {
using bf16=__hip_bfloat16;
using bf16x8=__attribute__((ext_vector_type(8)))short;
using s16x4=__attribute__((ext_vector_type(4)))short;
using f32x16=__attribute__((ext_vector_type(16)))float;
using u32x4=__attribute__((ext_vector_type(4)))unsigned;
constexpr int BATCH=8,NHEAD=4,SEQ=4096,D=64,DM=256,OPITCH=1024;
constexpr int NW=8,QBLK=32,QB=QBLK*NW,KVBLK=64,NQB=SEQ/QB;
constexpr int ATTN_PITCH=DM, ATTN_UNIT_ROWS=QB;
__device__ __forceinline__ int crow(int r,int hi){return (r&3)+8*(r>>2)+4*hi;}
#define SBAR() __builtin_amdgcn_sched_barrier(0)
__device__ __forceinline__ void cmask(f32x16&p0,f32x16&p1,int jb,int qrel,int hi){
  const float NEG=-INFINITY; int kb=64*jb+4*hi;
  #pragma unroll
  for(int r=0;r<16;++r){int kv=kb+(r&3)+8*(r>>2); if(kv>qrel)p0[r]=NEG; if(kv+32>qrel)p1[r]=NEG;}
}

constexpr int NSLOT=3, SLOTB=8192;
constexpr int LDS_K=0, LDS_V=NSLOT*SLOTB, LDS_WS=2*NSLOT*SLOTB, LDS_OST=LDS_WS+NW*64*4, LDS_CK=LDS_OST+NW*4096, LDS_BYTES=LDS_CK+SEQ*4;
constexpr float C2=0.125f*1.4426950408889634f;
__device__ __forceinline__ void glds16(const void*gsrc,unsigned lds_dst){unsigned keep;
  asm volatile("s_mov_b32 %0, m0\n\ts_mov_b32 m0, %2\n\ts_nop 0\n\tglobal_load_lds_dwordx4 %1, off\n\ts_mov_b32 m0, %0":"=&s"(keep):"v"(gsrc),"s"(lds_dst):"memory");}
__device__ __forceinline__ float max3f(float a,float b,float c){float r;asm("v_max3_f32 %0, %1, %2, %3":"=v"(r):"v"(a),"v"(b),"v"(c));return r;}
__device__ __forceinline__ float max2f(float a,float b){float r;asm("v_max_f32_e32 %0, %1, %2":"=v"(r):"v"(a),"v"(b));return r;}
__device__ __forceinline__ float fadd_s(float a,float b){float r;asm("v_add_f32_e32 %0, %1, %2":"=v"(r):"v"(a),"v"(b));return r;}
__device__ __forceinline__ float fsub_s(float a,float b){float r;asm("v_sub_f32_e32 %0, %1, %2":"=v"(r):"v"(a),"v"(b));return r;}
typedef float f32x2_t __attribute__((ext_vector_type(2))); typedef __bf16 bf16x2_t __attribute__((ext_vector_type(2)));
__device__ __forceinline__ unsigned cvtpk_s(float lo,float hi){f32x2_t v={lo,hi};bf16x2_t b=__builtin_convertvector(v,bf16x2_t);return __builtin_bit_cast(unsigned,b);}
#define WAIT_BAR(N) asm volatile("s_waitcnt vmcnt(" #N ") lgkmcnt(0)\n\ts_barrier":::"memory")

__device__ __forceinline__ void qkt(f32x16&p0,f32x16&p1,const char*Kslot,const bf16x8*qr,const f32x16&c0,const f32x16&c1,int r32,int hi){
  const char*kb=Kslot+hi*1024+r32*16;
  #pragma unroll
  for(int d0=0;d0<4;++d0){
    const bf16x8 b0=*reinterpret_cast<const bf16x8*>(kb+d0*2048);
    const bf16x8 b1=*reinterpret_cast<const bf16x8*>(kb+d0*2048+512);
    if(d0==0){p0=__builtin_amdgcn_mfma_f32_32x32x16_bf16(b0,qr[0],c0,0,0,0);p1=__builtin_amdgcn_mfma_f32_32x32x16_bf16(b1,qr[0],c1,0,0,0);}
    else{p0=__builtin_amdgcn_mfma_f32_32x32x16_bf16(b0,qr[d0],p0,0,0,0);p1=__builtin_amdgcn_mfma_f32_32x32x16_bf16(b1,qr[d0],p1,0,0,0);}}
}
typedef __attribute__((address_space(3))) const char* lds_cptr;
typedef __attribute__((address_space(3))) const float* lds_fptr;
typedef float f32x4v __attribute__((ext_vector_type(4)));
typedef short v4i16_t __attribute__((ext_vector_type(4)));
__device__ __forceinline__ void kload8(bf16x8*kf,lds_cptr kp){
  kf[0]=*(const __attribute__((address_space(3))) bf16x8*)(kp);      kf[1]=*(const __attribute__((address_space(3))) bf16x8*)(kp+512);
  kf[2]=*(const __attribute__((address_space(3))) bf16x8*)(kp+2048); kf[3]=*(const __attribute__((address_space(3))) bf16x8*)(kp+2560);
  kf[4]=*(const __attribute__((address_space(3))) bf16x8*)(kp+4096); kf[5]=*(const __attribute__((address_space(3))) bf16x8*)(kp+4608);
  kf[6]=*(const __attribute__((address_space(3))) bf16x8*)(kp+6144); kf[7]=*(const __attribute__((address_space(3))) bf16x8*)(kp+6656);
}
__device__ __forceinline__ void kload2(bf16x8*kf,lds_cptr kp,int j){ kf[2*j]=*(const __attribute__((address_space(3))) bf16x8*)(kp+j*2048); kf[2*j+1]=*(const __attribute__((address_space(3))) bf16x8*)(kp+j*2048+512); }
__device__ __forceinline__ s16x4 vtr(lds_cptr p){ return __builtin_bit_cast(s16x4,__builtin_amdgcn_ds_read_tr16_b64_v4i16((__attribute__((address_space(3))) v4i16_t*)p)); }
__device__ __forceinline__ float rowmax(const f32x16&p0,const f32x16&p1){
  float a=max3f(p0[0],p0[1],p1[0]),b=max3f(p0[2],p0[3],p1[1]);a=max3f(a,p1[2],p1[3]);
  #pragma unroll
  for(int r=4;r<16;r+=4){a=max3f(a,p0[r],p0[r+1]);b=max3f(b,p0[r+2],p0[r+3]);a=max3f(a,p1[r],p1[r+1]);b=max3f(b,p1[r+2],p1[r+3]);}
  const float m=max2f(a,b);
  auto rr=__builtin_amdgcn_permlane32_swap(__float_as_uint(m),__float_as_uint(m),false,false);
  return max2f(__uint_as_float(rr[0]),__uint_as_float(rr[1]));
}
__device__ __forceinline__ void pv(f32x16*o,int vb,bf16x8 pa0,bf16x8 pa1,bf16x8 pa2,bf16x8 pa3){
  #pragma unroll
  for(int d0=0;d0<2;++d0){s16x4 lo[4],hi[4];
    #pragma unroll
    for(int ks=0;ks<4;++ks){
      asm volatile("ds_read_b64_tr_b16 %0,%1 offset:%c2":"=&v"(lo[ks]):"v"(vb),"i"(d0*4096+ks*1024):"memory");
      asm volatile("ds_read_b64_tr_b16 %0,%1 offset:%c2":"=&v"(hi[ks]):"v"(vb),"i"(d0*4096+ks*1024+512):"memory");}
    asm volatile("s_waitcnt lgkmcnt(0)":::"memory");SBAR();
    #define PK(k) (bf16x8){lo[k][0],lo[k][1],lo[k][2],lo[k][3],hi[k][0],hi[k][1],hi[k][2],hi[k][3]}
    o[d0]=__builtin_amdgcn_mfma_f32_32x32x16_bf16(pa0,PK(0),o[d0],0,0,0);
    o[d0]=__builtin_amdgcn_mfma_f32_32x32x16_bf16(pa1,PK(1),o[d0],0,0,0);
    o[d0]=__builtin_amdgcn_mfma_f32_32x32x16_bf16(pa2,PK(2),o[d0],0,0,0);
    o[d0]=__builtin_amdgcn_mfma_f32_32x32x16_bf16(pa3,PK(3),o[d0],0,0,0);
    #undef PK
  }
}

#ifndef ATTN_STORE16
#define ATTN_STORE16(p,v) (*(u32x4*)(p)=(v))
#endif
template<int THRL> __device__ __forceinline__ void attn_unit(int b,int h,int qb,const bf16*Q,const bf16*__restrict__ K,const bf16*__restrict__ V,bf16*O,const float*ckg,float*ssq,char*shm,const float skipthr){
  int tid=threadIdx.x; asm volatile("":"+v"(tid)); const int lane=tid&63,r32=lane&31,hi=lane>>5; const int wid=__builtin_amdgcn_readfirstlane(tid>>6);
  const long rowbase=(long)b*SEQ; const int q0=qb*QB;
  { float*ckl=(float*)(shm+LDS_CK); const int nk_=q0+QB; f32x4v c0_={0.f,0.f,0.f,0.f},c1_={0.f,0.f,0.f,0.f}; if(4*tid<nk_)c0_=*(const f32x4v*)(ckg+4*tid); if(2048+4*tid<nk_)c1_=*(const f32x4v*)(ckg+2048+4*tid);
    if(4*tid<nk_)*(f32x4v*)(ckl+4*tid)=c0_; if(2048+4*tid<nk_)*(f32x4v*)(ckl+2048+4*tid)=c1_; }
  int t0=0;
  { const int kmax=((q0+QB)/KVBLK-4)/2; const float cq=ckg[q0]; int lo=0,hi_=kmax;
    while(lo<hi_){ const int mid=(lo+hi_+1)>>1; if(ckg[128*mid-1]-cq>=skipthr)lo=mid; else hi_=mid-1; }
    t0=__builtin_amdgcn_readfirstlane(2*lo); }
  const lds_fptr ckp0=(lds_fptr)(shm)+LDS_CK/4+4*hi+t0*KVBLK;
  const bf16*Qw=Q+(rowbase+q0+wid*QBLK)*DM+h*D;
  const bf16*Kh=K+(rowbase+(long)t0*KVBLK)*DM+h*D,*Vh=V+(rowbase+(long)t0*KVBLK)*DM+h*D;
  const unsigned lds0=(unsigned)(uintptr_t)shm;
  float*wsf=(float*)(shm+LDS_WS)+wid*64;
  const bf16*ksrc=Kh+(long)lane*DM+wid*8;
  const bf16*vsrc=Vh+(long)(16*(wid&3)+(lane>>2))*DM+(wid>>2)*32+(lane&3)*8;
  const unsigned kdst=lds0+LDS_K+wid*1024, vdst=lds0+LDS_V+wid*1024;
  #define DMA_K(t,slot) glds16(ksrc+(long)(t)*KVBLK*DM,(unsigned)__builtin_amdgcn_readfirstlane(kdst+(slot)))
  #define DMA_V(t,slot) glds16(vsrc+(long)(t)*KVBLK*DM,(unsigned)__builtin_amdgcn_readfirstlane(vdst+(slot)))
  const int vb0=(int)(lds0+LDS_V)+((lane>>4)&1)*32+(lane&3)*8+(4*hi+((lane&15)>>2))*64;
  const char*Kbase=shm+LDS_K; bf16x8 kf[8];
  const lds_cptr shm3=(lds_cptr)shm; const lds_cptr kp0=shm3+LDS_K+hi*1024+r32*16; const lds_cptr vp0=shm3+LDS_V+((lane>>4)&1)*32+(lane&3)*8+(4*hi+((lane&15)>>2))*64;
  const int NT=(q0+QB)/KVBLK-t0;
  DMA_K(0,0);DMA_V(0,0);DMA_K(1,SLOTB);
  bf16x8 qr[4];
  #pragma unroll
  for(int d0=0;d0<4;++d0)qr[d0]=*reinterpret_cast<const bf16x8*>(&Qw[(long)r32*DM+d0*16+hi*8]);
  float mhat=0.f,l_reg=0.f,nmh=0.f;f32x16 o[2];o[0]=f32x16{};o[1]=f32x16{};
  #define CINIT(C0,C1,t) do{ const lds_fptr cp_=ckp0+(t)*KVBLK; _Pragma("unroll") for(int g_=0;g_<4;++g_){ const f32x4v a_=*(const __attribute__((address_space(3))) f32x4v*)(cp_+8*g_), b_=*(const __attribute__((address_space(3))) f32x4v*)(cp_+32+8*g_); \
      _Pragma("unroll") for(int i_=0;i_<4;++i_){C0[4*g_+i_]=nmh-a_[i_];C1[4*g_+i_]=nmh-b_[i_];} } }while(0)
  const int qrel=wid*QBLK+r32;
  #define CMASK(P0,P1,t) do{int jb_=(t)-(NT-4); if(jb_>=0)cmask(P0,P1,jb_,qrel,hi);}while(0)
  bool resc=false;
  #define START(P0,P1) do{ const float rm=rowmax(P0,P1); resc=false; \
    { const float dl=rm; mhat=fadd_s(mhat,dl); \
      _Pragma("unroll") for(int r=0;r<16;++r){P0[r]=fsub_s(P0[r],dl);P1[r]=fsub_s(P1[r],dl);} \
      nmh=-mhat; } \
    _Pragma("unroll") for(int r=0;r<16;++r)P0[r]=__builtin_amdgcn_exp2f(P0[r]); }while(0)
  #define RESC() do{ if(resc){ asm volatile("s_waitcnt lgkmcnt(0)":::"memory"); \
      _Pragma("unroll") for(int d_=0;d_<2;++d_) _Pragma("unroll") for(int r=0;r<16;++r)o[d_][r]*=wsf[crow(r,hi)]; } }while(0)
  f32x16 pA0,pA1,pB0,pB1;
  int sl_prev=0,sl_cur=0,sl_next=SLOTB;
  #define ROT() do{sl_prev=sl_cur;sl_cur=sl_next;sl_next=(sl_next==(NSLOT-1)*SLOTB)?0:sl_next+SLOTB;}while(0)
  DMA_K(2,2*SLOTB);
  WAIT_BAR(3);
  { f32x16 ci0,ci1; CINIT(ci0,ci1,0); qkt(pA0,pA1,Kbase,qr,ci0,ci1,r32,hi); } asm volatile("s_nop 15\n\ts_nop 7":"+v"(pA0),"+v"(pA1));CMASK(pA0,pA1,0);
  START(pA0,pA1);
  _Pragma("unroll") for(int r=0;r<16;++r)pA1[r]=__builtin_amdgcn_exp2f(pA1[r]);
  WAIT_BAR(0);
  DMA_K(3,0);DMA_V(1,SLOTB);
  ROT();
  kload8(kf,kp0+sl_cur);
  WAIT_BAR(2);
  s16x4 vlo[8],vhi[8]; u32x4 pw0,pw1,pw2,pw3;
  #define PKW(P,B) cvtpk_s(P[B],P[B+1])
  #define PAF(k) __builtin_bit_cast(bf16x8,pw##k)
  #define VFR(i) (bf16x8){vlo[i][0],vlo[i][1],vlo[i][2],vlo[i][3],vhi[i][0],vhi[i][1],vhi[i][2],vhi[i][3]}
  #define PIN(x) asm volatile("":"+v"(x))
  #define MX3(a,b,c) __builtin_fmaxf(__builtin_fmaxf((a),(b)),(c))
  #define GAPA(MF,A0,A1,A2,A3,W0,W1,PW) do{ MF; sacc+=A0; sacc+=A1; sacc+=A2; sacc+=A3; PIN(sacc); W0; W1; PIN(PW); SBAR(); }while(0)
  #define EX(v) __builtin_amdgcn_exp2f(v)
  #define GAPB(MF,X,B) do{ MF; X[B]=EX(X[B]); X[B+1]=EX(X[B+1]); X[B+2]=EX(X[B+2]); X[B+3]=EX(X[B+3]); PIN(X); SBAR(); }while(0)
  #define VRD(i) do{ vlo[i]=vtr(vp_+(((i)>>2)*4096+((i)&3)*1024)); vhi[i]=vtr(vp_+(((i)>>2)*4096+((i)&3)*1024+512)); }while(0)
  #define KRD(G,j) do{ if(G){ kload2(kf,kp0+sl_next,j); SBAR(); } }while(0)
  #define STEP(C0,C1,P0,P1,t,GK,GV,GL) do{ SBAR(); \
    CINIT(C0,C1,t); SBAR(); \
    const lds_cptr vp_=vp0+sl_prev; \
    VRD(0); SBAR(); float sacc=(P0[0]+P0[1]); \
    GAPA(C0=__builtin_amdgcn_mfma_f32_32x32x16_bf16(kf[0],qr[0],C0,0,0,0), P0[2],P0[3],P0[4],P0[5],     pw0[0]=PKW(P0,0), pw0[1]=PKW(P0,2), pw0); \
    VRD(4); SBAR(); GAPA(C1=__builtin_amdgcn_mfma_f32_32x32x16_bf16(kf[1],qr[0],C1,0,0,0), P0[6],P0[7],P0[8],P0[9],     pw0[2]=PKW(P0,4), pw0[3]=PKW(P0,6), pw0); \
    VRD(1); SBAR(); GAPA(C0=__builtin_amdgcn_mfma_f32_32x32x16_bf16(kf[2],qr[1],C0,0,0,0),   P0[10],P0[11],P0[12],P0[13], pw1[0]=PKW(P0,8), pw1[1]=PKW(P0,10), pw1); \
    VRD(5); SBAR(); GAPA(C1=__builtin_amdgcn_mfma_f32_32x32x16_bf16(kf[3],qr[1],C1,0,0,0),   P0[14],P0[15],P1[0],P1[1],   pw1[2]=PKW(P0,12),pw1[3]=PKW(P0,14), pw1); \
    VRD(2); SBAR(); GAPA(C0=__builtin_amdgcn_mfma_f32_32x32x16_bf16(kf[4],qr[2],C0,0,0,0),   P1[2],P1[3],P1[4],P1[5],     pw2[0]=PKW(P1,0), pw2[1]=PKW(P1,2), pw2); \
    VRD(6); SBAR(); GAPA(C1=__builtin_amdgcn_mfma_f32_32x32x16_bf16(kf[5],qr[2],C1,0,0,0),   P1[6],P1[7],P1[8],P1[9],     pw2[2]=PKW(P1,4), pw2[3]=PKW(P1,6), pw2); \
    VRD(3); SBAR(); GAPA(C0=__builtin_amdgcn_mfma_f32_32x32x16_bf16(kf[6],qr[3],C0,0,0,0),   P1[10],P1[11],P1[12],P1[13], pw3[0]=PKW(P1,8), pw3[1]=PKW(P1,10), pw3); \
    VRD(7); SBAR(); GAPA(C1=__builtin_amdgcn_mfma_f32_32x32x16_bf16(kf[7],qr[3],C1,0,0,0),   P1[14],P1[15],0.f,0.f,       pw3[2]=PKW(P1,12),pw3[3]=PKW(P1,14), pw3); \
    l_reg+=sacc; \
    if(GK){DMA_K((t)+3,sl_cur);} if(GV){DMA_V((t)+1,sl_next);} \
    CMASK(C0,C1,t); \
    { float a=MX3(C0[0],C0[1],C1[0]),b=MX3(C0[2],C0[3],C1[1]); a=MX3(a,C1[2],C1[3]); \
      _Pragma("unroll") for(int r=4;r<16;r+=4){a=MX3(a,C0[r],C0[r+1]);b=MX3(b,C0[r+2],C0[r+3]);a=MX3(a,C1[r],C1[r+1]);b=MX3(b,C1[r+2],C1[r+3]);} \
      float rm=__builtin_fmaxf(a,b); { auto rr=__builtin_amdgcn_permlane32_swap(__float_as_uint(rm),__float_as_uint(rm),false,false); rm=__builtin_fmaxf(__uint_as_float(rr[0]),__uint_as_float(rr[1])); } \
      resc=false; \
      if(__builtin_expect(__any(rm>(float)THRL),0)){ const float dl=__builtin_fmaxf(rm,0.f); mhat+=dl; \
        _Pragma("unroll") for(int r=0;r<16;++r){C0[r]-=dl;C1[r]-=dl;} \
        nmh=-mhat; \
        const float f=__builtin_amdgcn_exp2f(-dl); l_reg*=f; if(hi==0)wsf[r32]=f; resc=true; } } \
    SBAR(); \
    GAPB(o[0]=__builtin_amdgcn_mfma_f32_32x32x16_bf16(PAF(0),VFR(0),o[0],0,0,0), C0,0); \
    GAPB(o[1]=__builtin_amdgcn_mfma_f32_32x32x16_bf16(PAF(0),VFR(4),o[1],0,0,0), C0,4); \
    KRD(GL,0); GAPB(o[0]=__builtin_amdgcn_mfma_f32_32x32x16_bf16(PAF(1),VFR(1),o[0],0,0,0), C0,8); \
    KRD(GL,1); GAPB(o[1]=__builtin_amdgcn_mfma_f32_32x32x16_bf16(PAF(1),VFR(5),o[1],0,0,0), C0,12); \
    KRD(GL,2); GAPB(o[0]=__builtin_amdgcn_mfma_f32_32x32x16_bf16(PAF(2),VFR(2),o[0],0,0,0), C1,0); \
    KRD(GL,3); GAPB(o[1]=__builtin_amdgcn_mfma_f32_32x32x16_bf16(PAF(2),VFR(6),o[1],0,0,0), C1,4); \
    GAPB(o[0]=__builtin_amdgcn_mfma_f32_32x32x16_bf16(PAF(3),VFR(3),o[0],0,0,0), C1,8); \
    GAPB(o[1]=__builtin_amdgcn_mfma_f32_32x32x16_bf16(PAF(3),VFR(7),o[1],0,0,0), C1,12); \
    }while(0)
  int t=1;
  #undef CMASK
  #define CMASK(P0,P1,t) do{}while(0)
  for(;t+5<NT;t+=2){
    STEP(pB0,pB1,pA0,pA1,t,true,true,true);     WAIT_BAR(2); RESC(); ROT();
    STEP(pA0,pA1,pB0,pB1,t+1,true,true,true);   WAIT_BAR(2); RESC(); ROT();
  }
  #undef CMASK
  #define CMASK(P0,P1,t) do{int jb_=(t)-(NT-4); if(jb_>=0)cmask(P0,P1,jb_,qrel,hi);}while(0)
  #define ENDW(tt) do{ if((tt)+3<NT){WAIT_BAR(2);} else if((tt)+2<NT){WAIT_BAR(1);} else {WAIT_BAR(0);} }while(0)
  for(;t+1<NT;t+=2){
    STEP(pB0,pB1,pA0,pA1,t,(t+3<NT),(t+1<NT),(t+1<NT));       ENDW(t);   RESC(); ROT();
    STEP(pA0,pA1,pB0,pB1,t+1,(t+4<NT),(t+2<NT),(t+2<NT));     ENDW(t+1); RESC(); ROT();
  }
  STEP(pB0,pB1,pA0,pA1,NT-1,false,false,false); RESC();
  { float sacc=pB0[0]+pB0[1]; _Pragma("unroll") for(int r=2;r<16;++r)sacc+=pB0[r]; _Pragma("unroll") for(int r=0;r<16;++r)sacc+=pB1[r]; l_reg+=sacc;
    pw0=(u32x4){PKW(pB0,0),PKW(pB0,2),PKW(pB0,4),PKW(pB0,6)};pw1=(u32x4){PKW(pB0,8),PKW(pB0,10),PKW(pB0,12),PKW(pB0,14)};pw2=(u32x4){PKW(pB1,0),PKW(pB1,2),PKW(pB1,4),PKW(pB1,6)};pw3=(u32x4){PKW(pB1,8),PKW(pB1,10),PKW(pB1,12),PKW(pB1,14)};
    SBAR(); pv(o,vb0+sl_cur,PAF(0),PAF(1),PAF(2),PAF(3)); }
  #undef PKW
  #undef PAF
  #undef VFR
  #undef PIN
  #undef MX3
  #undef GAPA
  #undef GAPB
  #undef EX
  #undef VRD
  #undef KRD
  #undef STEP
  #undef ENDW
  {auto rr=__builtin_amdgcn_permlane32_swap(__float_as_uint(l_reg),__float_as_uint(l_reg),false,false);l_reg=__uint_as_float(rr[0])+__uint_as_float(rr[1]);}
  if(hi==0)wsf[32+r32]=l_reg;asm volatile("s_waitcnt lgkmcnt(0)":::"memory");
  float rli[16];
  #pragma unroll
  for(int r=0;r<16;++r)rli[r]=__builtin_amdgcn_rcpf(wsf[32+crow(r,hi)]);
  bf16*Ow=O+(rowbase+q0+wid*QBLK)*OPITCH; float*sq=ssq+(rowbase+q0+wid*QBLK)*16;
  { bf16*stg=(bf16*)(shm+LDS_OST)+wid*2048;
    #pragma unroll
    for(int r=0;r<16;++r){const int orow=crow(r,hi);
      #pragma unroll
      for(int d0=0;d0<2;++d0)stg[orow*64+d0*32+r32]=__float2bfloat16(o[d0][r]*rli[r]);}
    asm volatile("s_waitcnt lgkmcnt(0)":::"memory");
    #pragma unroll
    for(int i=0;i<4;++i){const int row=i*8+(lane>>3),ch=lane&7; const u32x4 v=*(const u32x4*)(stg+row*64+ch*8); ATTN_STORE16(Ow+(long)row*OPITCH+ch*8,v);
      float s_=0.f; _Pragma("unroll") for(int e_=0;e_<4;++e_){const float lo_=__builtin_bit_cast(float,v[e_]<<16),hi_=__builtin_bit_cast(float,v[e_]&0xffff0000u); s_+=lo_*lo_+hi_*hi_;}
      s_+=__shfl_xor(s_,1);s_+=__shfl_xor(s_,2);s_+=__shfl_xor(s_,4); if(ch==0)sq[row*16]=s_; } }
  asm volatile("s_waitcnt lgkmcnt(0)\n\ts_barrier":::"memory");
  #undef DMA_K
  #undef DMA_V
  #undef CMASK
  #undef START
  #undef RESC
  #undef ROT
  #undef CINIT
}
constexpr int ATTN_LDS_BYTES=LDS_BYTES;
#undef SBAR
#undef WAIT_BAR
}

__device__ __forceinline__ void tr_item64(const float* W, int ldw, int k0, int ns0, bf16_t* WT, int ldt, int drow0, const float* ksc, LAS float* scr, int lane) {
    const int c4 = (lane & 15) * 4, r0 = lane >> 4;
#pragma unroll 4
    for (int i = 0; i < 16; ++i) { const int kk = 4 * i + r0; f32x4 v = *(const f32x4*)(W + (size_t)(k0 + kk) * ldw + ns0 + c4);
        if (ksc) { const float s = ksc[k0 + kk]; v = v * s; }
        LAS float* d = scr + kk * 65 + c4; d[0] = v[0]; d[1] = v[1]; d[2] = v[2]; d[3] = v[3]; }
    LDS_WAIT(); asm volatile("" ::: "memory");
    const int c = lane & 7;
#pragma unroll
    for (int j = 0; j < 8; ++j) { const int n = (lane >> 3) + 8 * j; const LAS float* s = scr + (8 * c) * 65 + n;
        u32x4 o; o.x = pk2(s[0], s[65]); o.y = pk2(s[130], s[195]); o.z = pk2(s[260], s[325]); o.w = pk2(s[390], s[455]);
        *(u32x4*)(WT + (size_t)(drow0 + n) * ldt + k0 + 8 * c) = o; }
    LDS_WAIT(); asm volatile("" ::: "memory");
}
struct TrItem { const float* W; unsigned char* WT; const float* ksc; int k0, ns0, drow0; };
__device__ __forceinline__ void tr8_issue(const TrItem& t, f32x4 (&vv)[16], int lane) {
    const int c4 = (lane & 15) * 4, r0 = lane >> 4;
#pragma unroll
    for (int i = 0; i < 16; ++i) { const int kk = 4 * i + r0; vv[i] = __builtin_nontemporal_load((const f32x4*)(t.W + (size_t)(t.k0 + kk) * DM + t.ns0 + c4)); }
}
__device__ __forceinline__ void tr8_finish(const TrItem& t, const f32x4 (&vv)[16], LAS float* scr, int lane) {
    const int c4 = (lane & 15) * 4, r0 = lane >> 4;
#pragma unroll
    for (int i = 0; i < 16; ++i) { const int kk = 4 * i + r0; const float sc = t.ksc ? t.ksc[t.k0 + kk] * WSCALE : WSCALE; const f32x4 v = vv[i] * sc;
        LAS float* d = scr + kk * 65 + c4; d[0] = v[0]; d[1] = v[1]; d[2] = v[2]; d[3] = v[3]; }
    LDS_WAIT(); asm volatile("" ::: "memory");
    const int c = lane & 7;
#pragma unroll
    for (int j = 0; j < 8; ++j) { const int n = (lane >> 3) + 8 * j; const LAS float* s = scr + (8 * c) * 65 + n;
        u32x2 o; o.x = pk4_fp8(s[0], s[65], s[130], s[195]); o.y = pk4_fp8(s[260], s[325], s[390], s[455]);
        *(u32x2*)(t.WT + (size_t)(t.drow0 + n) * DM + t.k0 + 8 * c) = o; }
    LDS_WAIT(); asm volatile("" ::: "memory");
}
constexpr int CNIT = 3 * NE * 256;
#ifndef CONV_P0N
#define CONV_P0N CNIT
#endif
#ifndef MIXPREP_HOST
#define MIXPREP_HOST 1
#endif
#ifndef MIX_KC
#define MIX_KC 0
#endif
#ifndef CONV_P0K
#define CONV_P0K 12288
#endif
#ifndef CONV_P0S
#define CONV_P0S 18432
#endif
constexpr int CQ_WORD = 8448;
__device__ __forceinline__ void ce_item(const Args& a, int zq, int g, TrItem& t) {
    const int l = g >= CNIT ? 1 : 0, it = g - l * CNIT;
    const int mat = it / (NE * 256), r = it % (NE * 256), e = r >> 8, nb = (r >> 4) & 15, kb = r & 15;
    t.k0 = 64 * kb; t.ns0 = 64 * nb;
    const size_t wo = ((size_t)l * NE + e) * DM * DM;
    unsigned char* wgu_t = (a.ws + zq) + WS_WGU + ((size_t)l * NE + e) * 2048 * DM;
    if (mat == 0) { t.W = a.in[I_EWG + zq] + wo; t.WT = wgu_t; t.ksc = a.in[I_FFNG + zq] + l * DM; t.drow0 = (nb >> 1) * 256 + (nb & 1) * 64; }
    else if (mat == 1) { t.W = a.in[I_EWU + zq] + wo; t.WT = wgu_t; t.ksc = a.in[I_FFNG + zq] + l * DM; t.drow0 = (nb >> 1) * 256 + 128 + (nb & 1) * 64; }
    else { t.W = a.in[I_EWD + zq] + wo; t.WT = (a.ws + zq) + WS_WD + wo; t.ksc = nullptr; t.drow0 = 64 * nb; }
}
__device__ __forceinline__ void conv_static(const Args& a, int zq, const int s0, const int e0, int w0, int nw, LAS float* scr, int lane) {
    f32x4 va[16], vb[16]; TrItem ta, tb;
    int it = s0 + w0;
    if (it < e0) { ce_item(a, zq, it, ta); tr8_issue(ta, va, lane); }
    while (it < e0) {
        int nx = it + nw; if (nx < e0) { ce_item(a, zq, nx, tb); tr8_issue(tb, vb, lane); }
        tr8_finish(ta, va, scr, lane); it = nx; if (it >= e0) break;
        nx = it + nw; if (nx < e0) { ce_item(a, zq, nx, ta); tr8_issue(ta, va, lane); }
        tr8_finish(tb, vb, scr, lane); it = nx;
    }
}
__device__ __forceinline__ void conv_pull(const Args& a, int zq, const int limit, const unsigned stopthr, const bool may_claim, LAS unsigned char* lds, int tid, int wave, int lane) {
    unsigned long long* q64 = (unsigned long long*)((unsigned*)(a.ws + zq + WS_CTL) + CQ_WORD);
    volatile LAS int* cw = (volatile LAS int*)(lds + MISC_OFF + 128);
    LAS float* scr = (LAS float*)(lds + wave * 16640);
    f32x4 va[16], vb[16]; TrItem ta, tb; bool have_b = false;
    unsigned long long pre = 0ull; int have_pre = 0;
    for (int rnd = 0;; ++rnd) {
        if (tid == 0) { int p = cw[0] - 1, go = 1;
            if (p >= 0) { if (stopthr && __hip_atomic_load((unsigned*)q64 + 1, __ATOMIC_RELAXED, __HIP_MEMORY_SCOPE_AGENT) >= stopthr) go = 0; }
            else if (!may_claim) { go = 0; p = -1; }
            else { const unsigned long long v = have_pre ? pre : __hip_atomic_fetch_add(q64, 1ull, __ATOMIC_RELAXED, __HIP_MEMORY_SCOPE_AGENT); have_pre = 0;
                const unsigned lo = (unsigned)v, hi = (unsigned)(v >> 32);
                p = CONV_P0N + 16 * (int)(lo < (unsigned)CNIT ? lo : (unsigned)CNIT);
                if (p >= 2 * CNIT) { go = 0; p = -1; }
                else if (stopthr && hi >= stopthr) go = 0; }
            if (go && p >= limit) go = 0;
            cw[0] = go ? 0 : p + 1;
            cw[1 + (rnd & 1)] = go ? p : -1;
            if (go && may_claim) { pre = __hip_atomic_fetch_add(q64, 1ull, __ATOMIC_RELAXED, __HIP_MEMORY_SCOPE_AGENT); have_pre = 1; } }
        __syncthreads();
        const int p = cw[1 + (rnd & 1)];
        if (p < 0) break;
        ce_item(a, zq, p + 2 * wave, ta); tr8_issue(ta, va, lane);
        if (have_b) tr8_finish(tb, vb, scr, lane);
        ce_item(a, zq, p + 2 * wave + 1, tb); tr8_issue(tb, vb, lane); have_b = true;
        tr8_finish(ta, va, scr, lane);
    }
    if (have_b) tr8_finish(tb, vb, scr, lane);
}
#define HOST_NOTE() do { if (tid == 0) (void)__hip_atomic_fetch_add((unsigned long long*)((unsigned*)(ws + WS_CTL) + CQ_WORD), 1ull << 32, __ATOMIC_RELAXED, __HIP_MEMORY_SCOPE_AGENT); } while (0)
#define HOST_THR(hidx, n_long) ((unsigned)(G * (hidx) + (G - (n_long)) + 1))
__device__ __forceinline__ void apow(float lr, float li, float dt, int k, float& re, float& im) {
    const float mag = __builtin_amdgcn_exp2f((float)k * lr * dt * LOG2E);
    const double rev = (double)k * (double)li * (double)dt * 0.15915494309189535;
    const float fr = (float)(rev - __builtin_rint(rev));
    re = mag * __builtin_amdgcn_cosf(fr); im = mag * __builtin_amdgcn_sinf(fr);
}
__device__ __forceinline__ void ssm_setup(const Args& a, int zq, int lg, LAS float* Ar, LAS float* Ai, LAS float* bbr, LAS float* bbi, LAS float* cr, LAS float* ci, const int tid) {
    const float* lre = a.in[I_LRE + zq] + lg * 64; const float* lim = a.in[I_LIM + zq] + lg * 64; const float dt = expf(a.in[I_LDT + zq][lg]);
    for (int idx = tid; idx < 65 * 64; idx += NTHR) { const int k = idx >> 6, p = idx & 63; float re, im; apow(lre[p], lim[p], dt, k, re, im); Ar[idx] = re; Ai[idx] = im; }
    for (int idx = tid; idx < 1024; idx += NTHR) { const int p = idx >> 4;
        const float lr = lre[p], li = lim[p]; float are, aim; apow(lr, li, dt, 1, are, aim);
        const float den = lr * lr + li * li, nre = are - 1.0f, nim = aim, kre = (nre * lr + nim * li) / den, kim = (nim * lr - nre * li) / den;
        const float br = a.in[I_BRE + zq][(size_t)lg * 1024 + idx], bi = a.in[I_BIM + zq][(size_t)lg * 1024 + idx];
        bbr[idx] = kre * br - kim * bi; bbi[idx] = kre * bi + kim * br;
        cr[idx] = a.in[I_CRE + zq][(size_t)lg * 1024 + idx]; ci[idx] = a.in[I_CIM + zq][(size_t)lg * 1024 + idx]; }
    __syncthreads();
}
__device__ __forceinline__ void ssm_stage1(const Args& a, int zq, int unit, LAS unsigned char* lds, const int tid) {
    const int lg = unit >> 3, ks = unit & 7;
    LAS float* Ar = (LAS float*)lds; LAS float* Ai = Ar + 65 * 64; LAS float* bbr = Ai + 65 * 64; LAS float* bbi = bbr + 1024; LAS float* cr = bbi + 1024; LAS float* ci = cr + 1024;
    ssm_setup(a, zq, lg, Ar, Ai, bbr, bbi, cr, ci, tid);
    const float* dsk = a.in[I_SD + zq] + lg * 16; float* mt = (float*)((a.ws + zq) + WS_MTAB) + (size_t)lg * 64 * 256;
    for (int idx = tid; idx < 8 * 256; idx += NTHR) { const int k = 8 * ks + (idx >> 8), c1 = (idx >> 4) & 15, c0 = idx & 15; float s = 0.f;
        for (int p = 0; p < 64; ++p) { const float xr = cr[c1 * 64 + p], xi = ci[c1 * 64 + p], ar = Ar[k * 64 + p], ai = Ai[k * 64 + p];
            const float wr_ = xr * ar - xi * ai, wi_ = xr * ai + xi * ar; s += wr_ * bbr[p * 16 + c0] - wi_ * bbi[p * 16 + c0]; }
        if (k == 0 && c1 == c0) s += dsk[c0];
        mt[k * 256 + (idx & 255)] = s; }
    __syncthreads();
}
__device__ __forceinline__ void ssm_stage2(const Args& a, int zq, int unit, LAS unsigned char* lds, const int tid) {
    const int lg = unit >> 3, rs = unit & 7;
    LAS float* Ar = (LAS float*)lds; LAS float* Ai = Ar + 65 * 64; LAS float* bbr = Ai + 65 * 64; LAS float* bbi = bbr + 1024; LAS float* cr = bbi + 1024; LAS float* ci = cr + 1024; LAS float* Mt = ci + 1024;
    ssm_setup(a, zq, lg, Ar, Ai, bbr, bbi, cr, ci, tid);
    const float* mt = (const float*)((a.ws + zq) + WS_MTAB) + (size_t)lg * 64 * 256;
    for (int idx = tid; idx < (8 * rs + 8) * 256; idx += NTHR) Mt[idx] = mt[idx];
    __syncthreads();
    bf16_t* Wt = (bf16_t*)((a.ws + zq) + WS_WSSM) + (size_t)lg * 1024 * KSSM;
    for (int idx = tid; idx < 128 * 144; idx += NTHR) { const int row = 128 * rs + idx / 144, cc = idx % 144, j = row >> 4, c1 = row & 15; float v[8];
        if (cc < 128) { const int s = cc >> 1, c0 = (cc & 1) * 8;
#pragma unroll
            for (int i = 0; i < 8; ++i) v[i] = (s <= j) ? Mt[(j - s) * 256 + c1 * 16 + c0 + i] : 0.f;
        } else { const int q0 = (cc - 128) * 8;
#pragma unroll
            for (int i = 0; i < 8; ++i) { const int q = q0 + i, p = q & 63; const float xr = cr[c1 * 64 + p], xi = ci[c1 * 64 + p], ar = Ar[(j + 1) * 64 + p], ai = Ai[(j + 1) * 64 + p];
                v[i] = (q < 64) ? (xr * ar - xi * ai) : -(xr * ai + xi * ar); } }
        u32x4 o; o.x = pk2(v[0], v[1]); o.y = pk2(v[2], v[3]); o.z = pk2(v[4], v[5]); o.w = pk2(v[6], v[7]);
        *(u32x4*)(Wt + (size_t)row * KSSM + cc * 8) = o; }
    bf16_t* Gt = (bf16_t*)((a.ws + zq) + WS_GSSM) + (size_t)lg * 256 * 1024;
    for (int idx = tid; idx < 32 * 128; idx += NTHR) { const int r = idx >> 7, cc = idx & 127, q = (r < 16) ? 16 * rs + r : 128 + 16 * rs + (r - 16); float v[8];
        if (q < 128) { const int s = cc >> 1, c0 = (cc & 1) * 8, p = q & 63; const float ar = Ar[(63 - s) * 64 + p], ai = Ai[(63 - s) * 64 + p];
#pragma unroll
            for (int i = 0; i < 8; ++i) { const float br = bbr[p * 16 + c0 + i], bi = bbi[p * 16 + c0 + i]; v[i] = (q < 64) ? (ar * br - ai * bi) : (ar * bi + ai * br); }
        } else {
#pragma unroll
            for (int i = 0; i < 8; ++i) v[i] = 0.f; }
        u32x4 o; o.x = pk2(v[0], v[1]); o.y = pk2(v[2], v[3]); o.z = pk2(v[4], v[5]); o.w = pk2(v[6], v[7]);
        *(u32x4*)(Gt + (size_t)q * 1024 + cc * 8) = o; }
    __syncthreads();
}

__device__ __forceinline__ void xprep(const Args& a, int zq, int mode, int gw, int ngw, int lane) {
    const float* xs = a.in[I_X + zq]; const unsigned char* slab = (a.ws + zq) + WS_SLAB;
    bf16_t* xb = (bf16_t*)((a.ws + zq) + WS_XB); float* rinv = (float*)((a.ws + zq) + WS_RINV); float* flog = (float*)((a.ws + zq) + WS_FLOG);
    const float* wf = (const float*)((a.ws + zq) + WS_WF) + (mode == 1 ? 4 * DM : 0);
    f32x4 wq[4][4];
    if (mode != 2) {
#pragma unroll
        for (int q = 0; q < 4; ++q)
#pragma unroll
            for (int j = 0; j < 4; ++j) wq[q][j] = *(const f32x4*)(wf + q * DM + 4 * lane + 256 * j);
    }
    for (int row0 = gw; row0 < NTOK; row0 += 2 * ngw) {
        f32x4 v[2][4];
#pragma unroll
        for (int r = 0; r < 2; ++r) { const int row = row0 + r * ngw;
            if (row < NTOK) {
                if (mode == 0) {
#pragma unroll
                    for (int j = 0; j < 4; ++j) v[r][j] = __builtin_nontemporal_load((const f32x4*)(xs + (size_t)row * DM + 4 * lane + 256 * j));
                } else {
                    u32x2 wx[4]; unsigned ws_[4][4];
#pragma unroll
                    for (int j = 0; j < 4; ++j) wx[j] = __builtin_nontemporal_load((const u32x2*)(xb + (size_t)row * DM + 4 * lane + 256 * j));
#pragma unroll
                    for (int s = 0; s < 4; ++s)
#pragma unroll
                        for (int j = 0; j < 4; ++j) ws_[s][j] = __builtin_nontemporal_load((const unsigned*)(slab + ((size_t)row * 4 + s) * DM + 4 * lane + 256 * j));
#pragma unroll
                    for (int j = 0; j < 4; ++j) { f32x4 sm = {0.f, 0.f, 0.f, 0.f};
#pragma unroll
                        for (int s = 0; s < 4; ++s) { const f32x2 lo = __builtin_amdgcn_cvt_pk_f32_fp8((int)ws_[s][j], false), hi = __builtin_amdgcn_cvt_pk_f32_fp8((int)ws_[s][j], true); sm = sm + (f32x4){lo[0], lo[1], hi[0], hi[1]}; }
                        v[r][j] = (f32x4){bflo(wx[j].x), bfhi(wx[j].x), bflo(wx[j].y), bfhi(wx[j].y)} + sm * SLAB_UNSCALE; }
                }
            } else {
#pragma unroll
                for (int j = 0; j < 4; ++j) v[r][j] = (f32x4){0.f, 0.f, 0.f, 0.f};
            } }
        if (mode == 2) {
#pragma unroll
            for (int r = 0; r < 2; ++r) { const int row = row0 + r * ngw; if (row < NTOK) {
#pragma unroll
                for (int j = 0; j < 4; ++j) *(f32x4*)(a.out + (size_t)row * DM + 4 * lane + 256 * j) = v[r][j]; } }
            continue; }
        float red[2][5];
#pragma unroll
        for (int r = 0; r < 2; ++r) { const int row = row0 + r * ngw; float ss = 0.f;
#pragma unroll
            for (int j = 0; j < 4; ++j) { ss += (v[r][j][0] * v[r][j][0] + v[r][j][1] * v[r][j][1]) + (v[r][j][2] * v[r][j][2] + v[r][j][3] * v[r][j][3]);
                if (row < NTOK) { u32x2 w; w.x = pk2(v[r][j][0], v[r][j][1]); w.y = pk2(v[r][j][2], v[r][j][3]); *(u32x2*)(xb + (size_t)row * DM + 4 * lane + 256 * j) = w; } }
            red[r][0] = ss;
#pragma unroll
            for (int q = 0; q < 4; ++q) { float d = 0.f;
#pragma unroll
                for (int j = 0; j < 4; ++j) d += (v[r][j][0] * wq[q][j][0] + v[r][j][1] * wq[q][j][1]) + (v[r][j][2] * wq[q][j][2] + v[r][j][3] * wq[q][j][3]);
                red[r][1 + q] = d; } }
#pragma unroll
        for (int o = 1; o < 64; o <<= 1)
#pragma unroll
            for (int r = 0; r < 2; ++r)
#pragma unroll
                for (int q = 0; q < 5; ++q) red[r][q] += __shfl_xor(red[r][q], o);
#pragma unroll
        for (int r = 0; r < 2; ++r) { const int row = row0 + r * ngw; const float rs = 1.0f / sqrtf(red[r][0] * (1.0f / DM) + EPS);
            if (lane == 0 && row < NTOK) { rinv[row] = rs; *(f32x4*)(flog + (size_t)row * 4) = (f32x4){red[r][1] * rs, red[r][2] * rs, red[r][3] * rs, red[r][4] * rs}; } }
    }
}

#define XB_TMO      128
#define XB_XCNT(j)  (256  + 64 * (j))
#define XB_XSUB(j)  (1280 + 64 * (j))
#define XB_XGEN(j)  (2304 + 64 * (j))
#define XB_TOP      3328
#define XB_TOPGEN   3392
#define XCD_BAR_WORDS 3456
#define XB_SPIN_CAP (1u << 20)
__device__ __forceinline__ unsigned xb_ld(unsigned* p)              { return __hip_atomic_load(p, __ATOMIC_RELAXED, __HIP_MEMORY_SCOPE_AGENT); }
__device__ __forceinline__ unsigned xb_add(unsigned* p, unsigned v) { return __hip_atomic_fetch_add(p, v, __ATOMIC_RELAXED, __HIP_MEMORY_SCOPE_AGENT); }
__device__ __forceinline__ unsigned xb_xcc_id() { return (unsigned)__builtin_amdgcn_s_getreg((3 << 11) | 20) & 0xFu; }
#define XB_SPIN(cond, bar) do { unsigned _sp = 0; while (cond) { __builtin_amdgcn_s_sleep(1); \
    if ((++_sp & 255u) == 0u) { if (xb_ld(&(bar)[XB_TMO])) break; if (_sp > XB_SPIN_CAP) { atomicAdd(&(bar)[XB_TMO], 1u); break; } } } } while (0)
struct XcdBarrier { unsigned* bar; unsigned x; volatile LAS unsigned* st; };
__device__ __forceinline__ XcdBarrier xcd_barrier_post(unsigned* bar, volatile LAS unsigned* st) {
    XcdBarrier b; b.bar = bar; b.x = xb_xcc_id(); b.st = st;
    if (threadIdx.x == 0) (void)xb_add(&bar[XB_XCNT(b.x)], 1u);
    return b;
}
__device__ __forceinline__ void xcd_barrier_complete(unsigned* bar, unsigned x, unsigned& nloc, unsigned& nx) {
    const unsigned G = gridDim.x * gridDim.y * gridDim.z;
    unsigned sum, cnt, mine, sp = 0u;
    for (;;) {
        sum = 0u; cnt = 0u; mine = 0u;
#pragma unroll
        for (unsigned j = 0; j < 16; ++j) { const unsigned c = xb_ld(&bar[XB_XCNT(j)]); sum += c; cnt += (c > 0u) ? 1u : 0u; mine = (j == x) ? c : mine; }
        if (sum == G) break;
        __builtin_amdgcn_s_sleep(1);
        if ((++sp & 255u) == 0u) { if (xb_ld(&bar[XB_TMO])) break; if (sp > XB_SPIN_CAP) { atomicAdd(&bar[XB_TMO], 1u); break; } }
    }
    nloc = mine > 0u ? mine : 1u; nx = cnt > 0u ? cnt : 1u;
}
__device__ __forceinline__ void xcd_barrier(const XcdBarrier& b) {
    asm volatile("s_waitcnt vmcnt(0)" ::: "memory");
    __syncthreads();
    if (threadIdx.x == 0) {
        unsigned* bar = b.bar; asm volatile("" : "+s"(bar));
        __builtin_amdgcn_s_waitcnt(0);
        unsigned nloc = b.st[0], nx = b.st[1];
        if (nloc == 0u) { xcd_barrier_complete(bar, b.x, nloc, nx); b.st[0] = nloc; b.st[1] = nx; }
        const unsigned old = xb_add(&bar[XB_XSUB(b.x)], 1u);
        const unsigned gen = old / nloc;
        if (old + 1u == (gen + 1u) * nloc) {
            __builtin_amdgcn_fence(__ATOMIC_RELEASE, "agent");
            asm volatile("s_waitcnt vmcnt(0)" ::: "memory");
            const unsigned og = xb_add(&bar[XB_TOP], 1u);
            const unsigned tg = og / nx;
            if (og + 1u == (tg + 1u) * nx) xb_add(&bar[XB_TOPGEN], 1u);
            else XB_SPIN(xb_ld(&bar[XB_TOPGEN]) == tg, bar);
            __builtin_amdgcn_fence(__ATOMIC_ACQUIRE, "agent");
            xb_add(&bar[XB_XGEN(b.x)], 1u);
            asm volatile("s_waitcnt vmcnt(0)" ::: "memory");
        } else {
            XB_SPIN(xb_ld(&bar[XB_XGEN(b.x)]) == gen, bar);
            __builtin_amdgcn_fence(__ATOMIC_ACQUIRE, "agent");
            asm volatile("s_waitcnt vmcnt(0)" ::: "memory");
        }
    }
    __syncthreads();
}

constexpr int SPLIST[] = {0, 1, 2, 4, 5, 7, 8, 9, 11, 12};
constexpr int PH_PER_LAYER = sizeof(SPLIST) / sizeof(int), N_PHASES = 1 + NLAYER * PH_PER_LAYER;
__host__ __device__ constexpr int sp_of(int ph) { return SPLIST[(ph - 1) % PH_PER_LAYER]; }

template <unsigned MASK> __global__ void __launch_bounds__(NTHR, 2) mk(Args a) {
#define HAS(code) (((MASK) >> (code)) & 1u)
    extern __shared__ __attribute__((aligned(16))) unsigned char lds_raw[];
    LAS unsigned char* lds = (LAS unsigned char*)lds_raw;
    const int G = gridDim.x, bid = blockIdx.x, ngw = G * NWAVES;
#if MK_N_LAUNCHES
    { volatile LAS unsigned* misc = (volatile LAS unsigned*)(lds + MISC_OFF); if (threadIdx.x < 64) misc[threadIdx.x] = 0u; __syncthreads(); }
    XcdBarrier bar = xcd_barrier_post((unsigned*)(a.ws + WS_CTL) + 4096, (volatile LAS unsigned*)(lds + MISC_OFF) + 8);
#endif

#ifndef PROBE_CODE
#define PROBE_CODE -1
#define PROBE_REPS 0
#define PROBE_DRY 1
#endif
#ifndef PROBE_L0ONLY
#define PROBE_L0ONLY 1
#endif
    int probe_rep = 0;
    for (int ph = a.ph_lo; ph < a.ph_hi;) {
        int zq = 0; asm volatile("" : "+s"(zq));
        unsigned char* ws = a.ws + zq;
        int tid = threadIdx.x; asm volatile("" : "+v"(tid));
        const int lane = tid & 63, wave = __builtin_amdgcn_readfirstlane(tid >> 6), gw = bid * NWAVES + wave;
        int cv_limit = 0, cs_end = 0, cs_lo = -1, cs_w0 = gw, cs_nw = ngw; unsigned cv_thr = 0u;
        if (ph == N_PHASES) { if constexpr (HAS(14)) { xprep(a, zq, 2, gw, ngw, lane); } }
        else if (ph == 0) { if constexpr (HAS(0)) {
            LAS float* scr = (LAS float*)(lds + wave * 16640);
            for (int it = gw; it < NLAYER * 784; it += ngw) { const int l = it / 784; int r = it % 784;
                if (r < 384) { const int kb = r / 24, nb = r % 24; tr_item64(a.in[I_WIN + zq] + (size_t)l * DM * INC, INC, 64 * kb, 64 * nb + (nb >= 20 ? 4 : 0), (bf16_t*)(ws + WS_WIN) + (size_t)l * 1536 * DM, DM, 64 * nb, a.in[I_MIXG + zq] + l * DM, scr, lane); continue; } r -= 384;
                if (r < 128) { const int kb = r / 8, nb = r % 8; tr_item64(a.in[I_MWKV + zq] + (size_t)l * DM * 512, 512, 64 * kb, 64 * nb, (bf16_t*)(ws + WS_WKV) + (size_t)l * 512 * DM, DM, 64 * nb, a.in[I_MNG + zq] + l * DM, scr, lane); continue; } r -= 128;
                if (r < 256) { const int kb = r / 16, nb = r % 16; const int gsel = kb >> 2;
                    const float* gain = (gsel == 0 ? a.in[I_SOUTG + zq] : gsel == 1 ? a.in[I_POOLS + zq] : gsel == 2 ? a.in[I_FOUTG + zq] : a.in[I_MOUTG + zq]) + l * 256 - 256 * gsel;
                    tr_item64(a.in[I_WOUT + zq] + (size_t)l * DM * DM, DM, 64 * kb, 64 * nb, (bf16_t*)(ws + WS_WOUT) + (size_t)l * DM * DM, DM, 64 * nb, gain, scr, lane); continue; } r -= 256;
                { const int kb = r / 4, nb = r % 4; tr_item64(a.in[I_GLUW + zq] + (size_t)l * 65536, 256, 64 * kb, 64 * nb, (bf16_t*)(ws + WS_WGLU) + (size_t)l * 65536, 256, 64 * nb, nullptr, scr, lane); }
            }
            for (int idx = bid * NTHR + tid; idx < NLAYER * 256 * DM; idx += G * NTHR) { const int l = idx / (256 * DM), r = idx % (256 * DM), n = r / DM, k = r % DM;
                const float v = (n < 32) ? a.in[I_RW + zq][(size_t)l * DM * 32 + (size_t)k * 32 + n] * a.in[I_FFNG + zq][l * DM + k] : 0.f;
                ((bf16_t*)(ws + WS_WR))[idx] = (bf16_t)f2bf(v); }
            for (int idx = bid * NTHR + tid; idx < NLAYER * 65536; idx += G * NTHR) { const int l = idx >> 16, r = idx & 65535, n = r >> 8, k = r & 255, gi = n >> 6;
                const float v = ((k >> 6) == gi) ? a.in[I_POOLW + zq][(size_t)l * 16384 + gi * 4096 + (k & 63) * 64 + (n & 63)] : 0.f;
                ((bf16_t*)(ws + WS_WPOOL))[idx] = (bf16_t)f2bf(v); }
            for (int idx = bid * NTHR + tid; idx < NLAYER * 4 * DM; idx += G * NTHR) { const int l = idx / (4 * DM), r = idx % (4 * DM), q = r / DM, k = r % DM;
                ((float*)(ws + WS_WF))[idx] = a.in[I_WIN + zq][(size_t)l * DM * INC + (size_t)k * INC + 1280 + q] * a.in[I_MIXG + zq][l * DM + k]; }
            for (int row = gw; row < NMEM; row += ngw) { f32x4 v[4]; float ss = 0.f;
#pragma unroll
                for (int j = 0; j < 4; ++j) { v[j] = *(const f32x4*)(a.in[I_MEM + zq] + (size_t)row * DM + 4 * lane + 256 * j); ss += (v[j][0] * v[j][0] + v[j][1] * v[j][1]) + (v[j][2] * v[j][2] + v[j][3] * v[j][3]);
                    u32x2 w; w.x = pk2(v[j][0], v[j][1]); w.y = pk2(v[j][2], v[j][3]); *(u32x2*)((bf16_t*)(ws + WS_MEMB) + (size_t)row * DM + 4 * lane + 256 * j) = w; }
                const float rs = 1.0f / sqrtf(wave_sum(ss) * (1.0f / DM) + EPS); if (lane == 0) ((float*)(ws + WS_RINVM))[row] = rs; }
            cs_end = G > 64 ? CONV_P0K : CNIT; cs_lo = 0;
        } } else {
            const int l = (ph - 1) / PH_PER_LAYER, sp = sp_of(ph);
            if (sp == 0) { if constexpr (HAS(1)) {
                _Pragma("unroll 1") for (int pass = 0; pass < 2; ++pass) {
                    const int odd = (bid >> 3) & 1;
                    if (l == 0 && pass == 1 - odd) { __syncthreads(); for (int u = bid; u < NLAYER * 16 * 8; u += G) ssm_stage2(a, zq, u, lds, tid); __syncthreads(); }
                    else if (pass == (l == 0 ? odd : 0)) xprep(a, zq, l == 0 ? 0 : 1, gw, ngw, lane); }
            } } else if (sp == 1) { if constexpr (HAS(2)) {
                pg8::DenseSched S; S.init(ws + WS_XB, DM, 0, ws + WS_WIN + (size_t)l * 1536 * DM * 2, DM, 0, NTOK, 1536, 1, G, bid);
                pg8::EpiInProj E{(const float*)(ws + WS_RINV), ws, lds};
                pg8::gemm_phase(lds, DM, S, E);
                if (l == 0) { pg8::DenseSched S2; S2.init(ws + WS_MEMB, DM, 0, ws + WS_WKV, DM, (size_t)512 * DM * 2, NMEM, 512, 2, G, G - 1 - bid);
                    pg8::EpiKv E2{(const float*)(ws + WS_RINVM), (bf16_t*)(ws + WS_KVRAW)}; pg8::gemm_phase(lds, DM, S2, E2);
                    if (G > 64 && CONV_P0K < CONV_P0S && G - 1 - bid >= S2.nwg) { cs_lo = CONV_P0K; cs_end = CONV_P0S; cs_w0 = bid * NWAVES + wave; cs_nw = (G - S2.nwg) * NWAVES; } }
            } } else if (sp == 2) { if constexpr (HAS(3)) {
                bf16_t* qb = (bf16_t*)(ws + WS_Q); bf16_t* kb = (bf16_t*)(ws + WS_K); bf16_t* qmb = (bf16_t*)(ws + WS_QM); const bf16_t* ub = (const bf16_t*)(ws + WS_UB); bf16_t* dp = (bf16_t*)(ws + WS_DP);
                const int d0 = (4 * lane) & 63;
                const f32x4 gq = *(const f32x4*)(a.in[I_FQG + zq] + l * 64 + d0) * C2, gk = *(const f32x4*)(a.in[I_FKG + zq] + l * 64 + d0), gm = *(const f32x4*)(a.in[I_MQG + zq] + l * 64 + d0) * C2;
                { const int rstep = G > 64 ? (G - 32) * NWAVES : ngw; const int wsel = lane >> 4;
                  for (int run = (G > 64 && bid >= G - 32) ? NTOK / 16 : gw; run < NTOK / 16; run += rstep) { const int r0 = run * 16, pos0 = r0 & (SEQ - 1);
                    u32x2 cur[16], prv[16];
#pragma unroll
                    for (int k = 0; k < 16; ++k) { cur[k] = *(const u32x2*)(ub + (size_t)(r0 + k) * 256 + 4 * lane); prv[k] = *(const u32x2*)(ub + (size_t)(pos0 ? r0 - 16 + k : r0 + k) * 256 + 4 * lane); }
                    if (pos0 == 0) {
#pragma unroll
                        for (int k = 0; k < 16; ++k) prv[k] = (u32x2){0u, 0u}; }
#define MP_F4(w_) ((f32x4){bflo((w_).x), bfhi((w_).x), bflo((w_).y), bfhi((w_).y)})
                    f32x4 sw[4];
#pragma unroll
                    for (int q = 0; q < 4; ++q) { sw[q] = (f32x4){0.f, 0.f, 0.f, 0.f};
#pragma unroll
                        for (int m = 16 - (2 << q); m < 16; ++m) sw[q] = sw[q] + MP_F4(prv[m]); }
#pragma unroll
                    for (int i = 0; i < 16; ++i) { const f32x4 vi = MP_F4(cur[i]);
#pragma unroll
                        for (int q = 0; q < 4; ++q) { const int w_ = 2 << q; const int j = i - w_;
                            const f32x4 out = j >= 0 ? MP_F4(cur[j >= 0 ? j : 0]) : MP_F4(prv[j < 0 ? 16 + j : 0]); sw[q] = sw[q] + vi - out; }
                        const f32x4 ssel = wsel == 0 ? sw[0] : wsel == 1 ? sw[1] : wsel == 2 ? sw[2] : sw[3];
                        const int pos = pos0 + i, wlen = 2 << wsel, cnt = (pos + 1) < wlen ? (pos + 1) : wlen;
                        const f32x4 d = ssel * (1.0f / (float)cnt) - vi; u32x2 o; o.x = pk2(d[0], d[1]); o.y = pk2(d[2], d[3]); *(u32x2*)(dp + (size_t)(r0 + i) * 256 + 4 * lane) = o; }
#pragma unroll
                    for (int which = 0; which < 3; ++which) { bf16_t* base = which == 0 ? qb : which == 1 ? kb : qmb; const f32x4 gg = which == 0 ? gq : which == 1 ? gk : gm;
                        u32x2 wv[16];
#pragma unroll
                        for (int k = 0; k < 16; ++k) wv[k] = *(const u32x2*)(base + (size_t)(r0 + k) * 256 + 4 * lane);
#pragma unroll
                        for (int k = 0; k < 16; ++k) { f32x4 v = MP_F4(wv[k]);
                            float ss = (v[0] * v[0] + v[1] * v[1]) + (v[2] * v[2] + v[3] * v[3]); ss += __shfl_xor(ss, 1); ss += __shfl_xor(ss, 2); ss += __shfl_xor(ss, 4); ss += __shfl_xor(ss, 8);
                            const float rs = 1.0f / sqrtf(ss * (1.0f / 64.0f) + EPS); v = v * gg * rs; u32x2 o; o.x = pk2(v[0], v[1]); o.y = pk2(v[2], v[3]);
                            *(u32x2*)(base + (size_t)(r0 + k) * 256 + 4 * lane) = o; } }
#undef MP_F4
                  } }
                if (l == 0) {
                    for (int r2 = (G > 64 && bid >= G - 32) ? NLAYER * NMEM : gw; r2 < NLAYER * NMEM; r2 += (G > 64 ? (G - 32) * NWAVES : ngw)) { const int ll = r2 / NMEM, row = r2 % NMEM; const bf16_t* src = (const bf16_t*)(ws + WS_KVRAW) + ((size_t)ll * NMEM + row) * 512;
                        const f32x4 gg = *(const f32x4*)(a.in[I_MKG + zq] + ll * 64 + d0);
                        const u32x2 w = *(const u32x2*)(src + 4 * lane); f32x4 v = {bflo(w.x), bfhi(w.x), bflo(w.y), bfhi(w.y)};
                        float ss = (v[0] * v[0] + v[1] * v[1]) + (v[2] * v[2] + v[3] * v[3]); ss += __shfl_xor(ss, 1); ss += __shfl_xor(ss, 2); ss += __shfl_xor(ss, 4); ss += __shfl_xor(ss, 8);
                        const float rs = 1.0f / sqrtf(ss * (1.0f / 64.0f) + EPS); v = v * gg * rs; u32x2 o; o.x = pk2(v[0], v[1]); o.y = pk2(v[2], v[3]);
                        *(u32x2*)((bf16_t*)(ws + WS_MK) + ((size_t)ll * NMEM + row) * 256 + 4 * lane) = o;
                        *(u32x2*)((bf16_t*)(ws + WS_MV) + ((size_t)ll * NMEM + row) * 256 + 4 * lane) = *(const u32x2*)(src + 256 + 4 * lane); } }
                for (int u = bid; u < 32; u += G) { const int b = u >> 2, h = u & 3; const float fb = a.in[I_FFB + zq][l * 4 + h]; const float* fl = (const float*)(ws + WS_FLOG);
                    float v[8], run = 0.f;
#pragma unroll
                    for (int i = 0; i < 8; ++i) { const float x = fl[((size_t)b * SEQ + tid * 8 + i) * 4 + h] + fb; const float ls = fminf(x, 0.f) - log1pf(__expf(-fabsf(x))); run += ls * LOG2E; v[i] = run; }
                    float inc = run;
#pragma unroll
                    for (int o = 1; o < 64; o <<= 1) { const float t = __shfl_up(inc, o); if (lane >= o) inc += t; }
                    LAS float* wt = (LAS float*)lds;
                    __syncthreads(); if (lane == 63) wt[wave] = inc; __syncthreads();
                    float base = inc - run; for (int w = 0; w < wave; ++w) base += wt[w];
                    float* ck = (float*)(ws + WS_CK) + (size_t)u * SEQ + tid * 8;
#pragma unroll
                    for (int i = 0; i < 8; ++i) ck[i] = base + v[i];
                    __syncthreads(); }
                { pg8::DenseSched S; S.init(ws + WS_UEXT, KSSM, (size_t)NCHUNK * KSSM * 2, ws + WS_GSSM + (size_t)l * 16 * 256 * 1024 * 2, 1024, (size_t)256 * 1024 * 2, NCHUNK, 256, 16, G, G - 1 - bid);
                  pg8::EpiS E{(float*)(ws + WS_S)}; pg8::gemm_phase(lds, 1024, S, E); }
                if (MIXPREP_HOST) { const int nl = G > 64 ? 32 : G; HOST_NOTE(); if (G - 1 - bid >= nl) { cv_limit = 2 * CNIT; cv_thr = HOST_THR(l == 0 ? 0 : 4, nl);
                    if (l == 0 && CONV_P0S < CNIT) { cs_lo = CONV_P0S; cs_end = CNIT; cs_w0 = bid * NWAVES + wave; cs_nw = (G - nl) * NWAVES; } } }
                { const int cs = G - 1 - bid;
                  if (cs < 32) { const int wg = pg8::xcd_remap(cs, 32), g = wg >> 1, pm = wg & 1;
                    VM_WAIT(); __syncthreads();
                    if (tid < 256) { const int p = tid & 63, b = 4 * pm + (tid >> 6); const int lg = l * 16 + g;
                        const float* Sg = (const float*)(ws + WS_S) + ((size_t)g * NCHUNK + b * 64) * 128 + p; bf16_t* H = (bf16_t*)(ws + WS_UEXT) + ((size_t)g * NCHUNK + b * 64) * KSSM + 1024 + p;
                        float sr[64], si[64];
#pragma unroll
                        for (int c = 0; c < 64; ++c) { sr[c] = Sg[(size_t)c * 128]; si[c] = Sg[(size_t)c * 128 + 64]; }
                        float ar, ai; apow(a.in[I_LRE + zq][lg * 64 + p], a.in[I_LIM + zq][lg * 64 + p], expf(a.in[I_LDT + zq][lg]), 64, ar, ai);
                        float hr = 0.f, hi_ = 0.f;
#pragma unroll
                        for (int c = 0; c < 64; ++c) { H[(size_t)c * KSSM] = (bf16_t)f2bf(hr); H[(size_t)c * KSSM + 64] = (bf16_t)f2bf(hi_);
                            const float nr = ar * hr - ai * hi_ + sr[c], ni = ar * hi_ + ai * hr + si[c]; hr = nr; hi_ = ni; } } } }
            } } else if (sp == 4) { if constexpr (HAS(5)) {
                const int kc = ((G & 7) == 0 && G >= 64) ? MIX_KC : 0, Ge = G - kc;
                if (bid >= Ge) { HOST_NOTE(); cv_limit = 2 * CNIT; cv_thr = HOST_THR(l == 0 ? 1 : 5, G - kc); }
                else {
                { pg8::DenseSched S; S.init(ws + WS_UEXT, KSSM, (size_t)NCHUNK * KSSM * 2, ws + WS_WSSM + (size_t)l * 16 * 1024 * KSSM * 2, KSSM, (size_t)1024 * KSSM * 2, NCHUNK, 1024, 16, Ge, bid);
                  pg8::EpiY E{(bf16_t*)(ws + WS_Z)}; pg8::gemm_phase(lds, KSSM, S, E); }
                { pg8::DenseSched S; S.init(ws + WS_DP, 256, 0, ws + WS_WPOOL + (size_t)l * 65536 * 2, 256, 0, NTOK, 256, 1, Ge, Ge - 1 - bid);
                  pg8::EpiPool E{(bf16_t*)(ws + WS_MERGED), (float*)(ws + WS_SSQ)}; pg8::gemm_phase(lds, 256, S, E); }
                float skipthr;
                { float mq = fabsf(a.in[I_FQG + zq][l * 64 + lane]), mk2 = fabsf(a.in[I_FKG + zq][l * 64 + lane]);
#pragma unroll
                  for (int o = 1; o < 64; o <<= 1) { mq = fmaxf(mq, __shfl_xor(mq, o)); mk2 = fmaxf(mk2, __shfl_xor(mk2, o)); }
                  skipthr = 2.0f * 1.02f * (64.0f * C2 * mq * mk2) + 72.0f; }
                { unsigned* ctr = (unsigned*)(ws + WS_CTL) + 8192 + 64 * l; volatile LAS int* qslot = (volatile LAS int*)(lds + MISC_OFF + 64); bool posted = false;
                  for (;;) {
                    __syncthreads(); if (tid == 0) *qslot = (int)__hip_atomic_fetch_add(ctr, 1u, __ATOMIC_RELAXED, __HIP_MEMORY_SCOPE_AGENT); __syncthreads();
                    const int uq = *qslot;
                    if (!posted && uq >= 1024 - Ge) { HOST_NOTE(); posted = true; }
                    if (uq >= 1024) break;
                    if (uq < 512) { const int qbk = 15 - (uq >> 5), b = (uq >> 2) & 7, h = uq & 3;
                        attn_body::attn_unit<8>(b, h, qbk, (const attn_body::bf16*)(ws + WS_Q), (const attn_body::bf16*)(ws + WS_K), (const attn_body::bf16*)(ws + WS_V), (attn_body::bf16*)(ws + WS_MERGED) + 512 + h * 64,
                                                (const float*)(ws + WS_CK) + (size_t)(b * 4 + h) * SEQ, (float*)(ws + WS_SSQ) + 8 + h, (char*)lds_raw, skipthr);
                    } else { const int m = uq - 512, b = m >> 6, h = (m >> 4) & 3, qbk = m & 15; const size_t qrow0 = (size_t)b * SEQ + qbk * 256;
                        att::unit(lds, (const bf16_t*)(ws + WS_QM), qrow0, (const bf16_t*)(ws + WS_MK) + (size_t)l * NMEM * 256, (const bf16_t*)(ws + WS_MV) + (size_t)l * NMEM * 256, (size_t)b * MEMLEN, h * 64, nullptr,
                                  4, false, (bf16_t*)(ws + WS_MERGED) + 768 + h * 64, (float*)(ws + WS_SSQ) + 12 + h); } } }
                }
            } } else if (sp == 5) { if constexpr (HAS(6)) {
                pg8::DenseSched S; S.init(ws + WS_Z, 256, 0, ws + WS_WGLU + (size_t)l * 65536 * 2, 256, 0, NTOK, 256, 1, G, bid);
                pg8::EpiGlu E{(const bf16_t*)(ws + WS_Z), a.in[I_GLUB + zq] + l * 256, (bf16_t*)(ws + WS_MERGED), (LAS float*)(lds + GLU_TAB_OFF)}; pg8::gemm_phase(lds, 256, S, E);
                { const int nn = G > 128 ? G - 128 : G, nb0 = G > 128 ? bid - 128 : bid;
                  if (nb0 >= 0 && lane < 48) { bf16_t* mg = (bf16_t*)(ws + WS_MERGED); const float* ssq = (const float*)(ws + WS_SSQ); const int rstep = nn * NWAVES;
                    for (int row0 = nb0 * NWAVES + wave; row0 < NTOK; row0 += 4 * rstep) {
                        f32x4 sp4[4]; u32x4 w[4][2];
#pragma unroll
                        for (int r = 0; r < 4; ++r) { const int row = (row0 + r * rstep) < NTOK ? (row0 + r * rstep) : NTOK - 1;
                            sp4[r] = *(const f32x4*)(ssq + (size_t)row * 16 + 4 + (lane >> 4) * 4);
#pragma unroll
                            for (int j = 0; j < 2; ++j) w[r][j] = *(const u32x4*)(mg + (size_t)row * DM + 256 + 16 * lane + 8 * j); }
#pragma unroll
                        for (int r = 0; r < 4; ++r) { const int row = row0 + r * rstep; if (row < NTOK) { const float rs = 1.0f / sqrtf(((sp4[r][0] + sp4[r][1]) + (sp4[r][2] + sp4[r][3])) * (1.0f / 256.0f) + EPS);
#pragma unroll
                            for (int j = 0; j < 2; ++j) { const u32x4 ww = w[r][j];
                                const f32x4 v0 = (f32x4){bflo(ww.x), bfhi(ww.x), bflo(ww.y), bfhi(ww.y)} * rs, v1 = (f32x4){bflo(ww.z), bfhi(ww.z), bflo(ww.w), bfhi(ww.w)} * rs;
                                *(u32x4*)(mg + (size_t)row * DM + 256 + 16 * lane + 8 * j) = pg8::pack8(v0, v1); } } } } } }
            } } else if (sp == 6) { if constexpr (HAS(7)) {
                bf16_t* mg = (bf16_t*)(ws + WS_MERGED); const float* ssq = (const float*)(ws + WS_SSQ);
                for (int row = gw; row < NTOK; row += ngw) { const f32x4 sp4 = *(const f32x4*)(ssq + (size_t)row * 16 + (lane >> 4) * 4);
                    const float rs = 1.0f / sqrtf(((sp4[0] + sp4[1]) + (sp4[2] + sp4[3])) * (1.0f / 256.0f) + EPS);
#pragma unroll
                    for (int j = 0; j < 2; ++j) { bf16_t* p = mg + (size_t)row * DM + 16 * lane + 8 * j; const u32x4 w = *(const u32x4*)p;
                        const f32x4 v0 = (f32x4){bflo(w.x), bfhi(w.x), bflo(w.y), bfhi(w.y)} * rs, v1 = (f32x4){bflo(w.z), bfhi(w.z), bflo(w.w), bfhi(w.w)} * rs; *(u32x4*)p = pg8::pack8(v0, v1); } }
            } } else if (sp == 7) { if constexpr (HAS(8)) {
                pg8::DenseSched S; S.init(ws + WS_MERGED, DM, 0, ws + WS_WOUT + (size_t)l * DM * DM * 2, DM, 0, NTOK, DM, 1, G, bid);
                pg8::EpiWout E{(bf16_t*)(ws + WS_XB), (float*)(ws + WS_SSQ2)}; pg8::gemm_phase(lds, DM, S, E);
            } } else if (sp == 8) { if constexpr (HAS(9)) {
                pg8::DenseSched S; S.init(ws + WS_XB, DM, (size_t)1024, ws + WS_WR + (size_t)l * 256 * DM * 2, DM, (size_t)1024, NTOK, 256, 2, G, bid);
                pg8::EpiRouter E{(float*)(ws + WS_LOGITP)}; pg8::gemm_phase(lds, DM / 2, S, E);
            } } else if (sp == 9) { if constexpr (HAS(10)) {
                LAS int* cntw = (LAS int*)lds;
                const int ntk = NTOK / NTHR;
                for (int tg = bid; tg < ntk; tg += G) { const int t = tg * NTHR + tid;
                    const f32x4* p0 = (const f32x4*)((const float*)(ws + WS_LOGITP) + (size_t)t * 32); const f32x4* p1 = (const f32x4*)((const float*)(ws + WS_LOGITP) + ((size_t)NTOK + t) * 32);
                    const f32x4* sq = (const f32x4*)((const float*)(ws + WS_SSQ2) + (size_t)t * 16); const f32x4* rbp = (const f32x4*)(a.in[I_RB + zq] + l * 32);
                    float ss = 0.f;
#pragma unroll
                    for (int i = 0; i < 4; ++i) { const f32x4 q = sq[i]; ss += (q[0] + q[1]) + (q[2] + q[3]); }
                    const float rs = 1.0f / sqrtf(ss * (1.0f / DM) + EPS);
                    float v[32];
#pragma unroll
                    for (int i = 0; i < 8; ++i) { const f32x4 x = (p0[i] + p1[i]) * rs + rbp[i]; v[4 * i] = x[0]; v[4 * i + 1] = x[1]; v[4 * i + 2] = x[2]; v[4 * i + 3] = x[3]; }
                    float val[4]; int idx[4];
#pragma unroll
                    for (int k = 0; k < 4; ++k) { float best = v[0]; int bi = 0;
#pragma unroll
                        for (int i = 1; i < 32; ++i) if (v[i] > best) { best = v[i]; bi = i; }
                        val[k] = best; idx[k] = bi;
#pragma unroll
                        for (int i = 0; i < 32; ++i) v[i] = (i == bi) ? -INFINITY : v[i]; }
                    float e1 = __expf(val[1] - val[0]), e2 = __expf(val[2] - val[0]), e3 = __expf(val[3] - val[0]); const float inv = 1.0f / (1.0f + e1 + e2 + e3);
                    const float gate[4] = {inv, e1 * inv, e2 * inv, e3 * inv};
                    int rk[4]; const unsigned long long lt = (1ull << lane) - 1ull;
                    __syncthreads();
#pragma unroll
                    for (int s = 0; s < 4; ++s) { int myc = 0; rk[s] = 0;
                        _Pragma("unroll 1") for (int e = 0; e < 32; ++e) { const unsigned long long mk_ = __ballot(idx[s] == e); if (idx[s] == e) rk[s] = __popcll(mk_ & lt); if (lane == e) myc = __popcll(mk_); }
                        if (lane < 32) cntw[(wave * 4 + s) * 32 + lane] = myc; }
                    __syncthreads();
                    *(f32x4*)((float*)(ws + WS_TKGATE) + (size_t)t * 4) = (f32x4){gate[0], gate[1], gate[2], gate[3]};
#pragma unroll
                    for (int s = 0; s < 4; ++s) { int base = 0; _Pragma("unroll 1") for (int q = 0; q < wave * 4 + s; ++q) base += cntw[q * 32 + idx[s]];
                        { u32x2 ent_; ent_.x = (unsigned)(t * 4 + s); ent_.y = __builtin_bit_cast(unsigned, gate[s]); ((u32x2*)(ws + WS_TGLIST))[((size_t)tg * 32 + idx[s]) * 512 + base + rk[s]] = ent_; } }
                    if (tid < 32) { int tot = 0; _Pragma("unroll 1") for (int q = 0; q < 32; ++q) tot += cntw[q * 32 + tid]; ((int*)(ws + WS_HIST))[tg * 32 + tid] = tot; }
                }
                { const int nconv = G > ntk ? G - ntk : G, cb = G > ntk ? bid - ntk : bid;
                  if (cb >= 0) { const bf16_t* xb = (const bf16_t*)(ws + WS_XB); unsigned char* x8 = ws + WS_X8; const float* ssq2 = (const float*)(ws + WS_SSQ2); const int rstep = nconv * NWAVES;
                    for (int row0 = cb * NWAVES + wave; row0 < NTOK; row0 += 8 * rstep) {
                        float sv[8]; u32x4 w[8][2];
#pragma unroll
                        for (int r = 0; r < 8; ++r) { const int row = (row0 + r * rstep) < NTOK ? (row0 + r * rstep) : NTOK - 1; sv[r] = ssq2[(size_t)row * 16 + (lane & 15)]; sv[r] = (lane < 16) ? sv[r] : 0.f;
#pragma unroll
                            for (int j = 0; j < 2; ++j) w[r][j] = *(const u32x4*)(xb + (size_t)row * DM + 8 * lane + 512 * j); }
#pragma unroll
                        for (int o = 1; o < 16; o <<= 1)
#pragma unroll
                            for (int r = 0; r < 8; ++r) sv[r] += __shfl_xor(sv[r], o);
#pragma unroll
                        for (int r = 0; r < 8; ++r) { const int row = row0 + r * rstep; const float rs = 1.0f / sqrtf(__shfl(sv[r], 0) * (1.0f / DM) + EPS);
                            if (row < NTOK) {
#pragma unroll
                                for (int j = 0; j < 2; ++j) { const u32x4 ww = w[r][j];
                                    u32x2 o; o.x = pk4_fp8(bflo(ww.x) * rs, bfhi(ww.x) * rs, bflo(ww.y) * rs, bfhi(ww.y) * rs); o.y = pk4_fp8(bflo(ww.z) * rs, bfhi(ww.z) * rs, bflo(ww.w) * rs, bfhi(ww.w) * rs);
                                    *(u32x2*)(x8 + (size_t)row * DM + 8 * lane + 512 * j) = o; } } } } } }
                if (l == 1 || CONV_P0N < CNIT) { cv_limit = l == 0 ? CNIT : 2 * CNIT; cv_thr = 0u; cs_end = cv_limit; }
            } } else if (sp == 10) { if constexpr (HAS(11)) {
                LAS int* tab = (LAS int*)lds;
                const int* hist = (const int*)(ws + WS_HIST);
                __syncthreads();
                if (tid < 32) { int c = 0; _Pragma("unroll 1") for (int q = 0; q < NTOK / NTHR; ++q) c += hist[q * 32 + tid]; tab[tid] = c; }
                __syncthreads();
                if (tid == 0) { int acc = 0; _Pragma("unroll 1") for (int e = 0; e < 32; ++e) { tab[32 + e] = acc; acc += (tab[e] + 255) & ~255; } }
                __syncthreads();
                int* row_tok = (int*)(ws + WS_ROWTOK); int* row_dst = (int*)(ws + WS_ROWDST); float* row_gate = (float*)(ws + WS_ROWGATE); float* row_rinv = (float*)(ws + WS_ROWRINV); const float* rinv2 = (const float*)(ws + WS_RINV2);
                for (int tg = bid; tg < NTOK / NTHR; tg += G) {
                    __syncthreads();
                    if (tid < 32) { int c = tab[32 + tid]; _Pragma("unroll 1") for (int q = 0; q < tg; ++q) c += hist[q * 32 + tid]; tab[64 + tid] = c; }
                    __syncthreads();
                    const int t = tg * NTHR + tid;
#pragma unroll
                    for (int s = 0; s < 4; ++s) { const int e = ((const int*)(ws + WS_TKIDX))[(size_t)t * 4 + s]; const int d = tab[64 + e] + ((const int*)(ws + WS_TKRANK))[(size_t)t * 4 + s];
                        row_tok[d] = t; row_dst[d] = t * 4 + s; row_gate[d] = ((const float*)(ws + WS_TKGATE))[(size_t)t * 4 + s]; row_rinv[d] = rinv2[t]; }
                }
                for (int e = bid; e < 32; e += G) { const int c = tab[e], p0 = tab[32 + e], pe = p0 + ((c + 255) & ~255);
                    for (int r = p0 + c + tid; r < pe; r += NTHR) { row_tok[r] = 0; row_dst[r] = -1; row_gate[r] = 0.f; row_rinv[r] = 0.f; } }
            } } else if (sp == 11 || sp == 12) { if constexpr (HAS(12) || HAS(13)) {
                LAS int* tab = (LAS int*)(lds + MOE_TAB_OFF); LAS unsigned char* mt_e = (LAS unsigned char*)(lds + MOE_TAB_OFF + 512);
                const int* hist = (const int*)(ws + WS_HIST);
                __syncthreads();
                LAS int* pfx = (LAS int*)lds;
                if (sp == 11 || MK_N_LAUNCHES != 1) {
                { const i32x4v h4 = *(const i32x4v*)(hist + 4 * tid); *(LAS i32x4v*)(pfx + 4 * tid) = h4; }
                __syncthreads();
                if (tid < 32) { int c = 0; _Pragma("unroll 8") for (int q = 0; q < NTOK / NTHR; ++q) { const int h = pfx[q * 32 + tid]; pfx[q * 32 + tid] = c; c += h; } tab[64 + tid] = c; tab[tid] = (c + 255) >> 8; }
                __syncthreads();
                if (tid == 0) { int acc = 0; _Pragma("unroll 1") for (int e = 0; e < 32; ++e) { tab[96 + e] = acc; acc += tab[e]; } tab[32] = acc; }
                __syncthreads();
                for (int t = tid; t < tab[32]; t += NTHR) { int e = 0; _Pragma("unroll") for (int q = 1; q < 32; ++q) e += (tab[96 + q] <= t) ? 1 : 0; mt_e[t] = (unsigned char)e; }
                __syncthreads(); }
                const int n_mt = tab[32];
                if (sp == 11) { if constexpr (HAS(12)) {
                    pg8::MoeSched<true> S; S.tok0 = (const LAS int*)(lds + BIAS_OFF); S.A = (const char*)(ws + WS_X8); S.B = (const char*)(ws + WS_WGU + (size_t)l * NE * 2048 * DM); S.lda = DM / 2; S.ldb = DM / 2; S.b_es = (size_t)2048 * DM; S.nN = 8; S.n_mt = n_mt; S.mt_e = mt_e; S.row_tok = (const int*)(ws + WS_ROWTOK);
                    const int T = 8 * n_mt, R = (T + G - 1) / G; int kc = 0;
                    if (l == 0 && (G & 7) == 0 && G >= 64) { kc = (((R * G - T) + R - 1) / R + 7) & ~7; kc = kc > 32 ? 32 : kc; }
                    const int Ge = G - kc, Lmain = T < R * Ge ? T : R * Ge; const bool cvb = bid >= Ge;
                    S.G = cvb ? kc : Ge; S.c = cvb ? bid - Ge : bid; S.L0 = cvb ? Lmain : 0; S.Lend = cvb ? T : Lmain;
                    S.note = (l == 0 && !cvb) ? (unsigned long long*)((unsigned*)(ws + WS_CTL) + CQ_WORD) : nullptr;
                    pg8::EpiMoe1 E{a.in[I_EBG + zq] + (size_t)l * NE * DM, a.in[I_EBU + zq] + (size_t)l * NE * DM, ws + WS_H, PROBE_DRY && probe_rep > 0};
                    {
                      int* row_tok = (int*)(ws + WS_ROWTOK); int* row_dst = (int*)(ws + WS_ROWDST); float* row_gate = (float*)(ws + WS_ROWGATE);
                      const u32x2* tglist = (const u32x2*)(ws + WS_TGLIST);
                      LAS int* tl = pfx + 64 * 32;
                      if (tid < 64) { int n = 0;
                          _Pragma("unroll 1") for (int b0 = 0;; b0 += 64) { pg8::Unit uu; uu.pm = 0; const bool has = S.next(b0 + tid, uu); const unsigned long long mk_ = __ballot(has);
                              if (has) tl[1 + n + __popcll(mk_ & ((1ull << tid) - 1ull))] = uu.pm; n += __popcll(mk_); if (mk_ != ~0ull) break; }
                          if (tid == 0) tl[0] = n; }
                      __syncthreads();
                      const int nrows = tl[0] * 256;
                      _Pragma("unroll 1") for (int base = 0; base < nrows; base += 4 * NTHR) {
                          int rowv[4], dv[4]; unsigned gb[4]; bool okv[4], inr[4];
                          _Pragma("unroll") for (int k = 0; k < 4; ++k) { const int idx = base + k * NTHR + tid; inr[k] = idx < nrows; okv[k] = false; rowv[k] = 0; dv[k] = 0; gb[k] = 0u;
                              if (inr[k]) { const int pm = tl[1 + (idx >> 8)], r = idx & 255, e = mt_e[pm], g = (pm - tab[96 + e]) * 256 + r; rowv[k] = pm * 256 + r;
                                  if (g < tab[64 + e]) { int lo = 0;
                                      _Pragma("unroll") for (int st = 32; st > 0; st >>= 1) { if (pfx[(lo + st) * 32 + e] <= g) lo += st; }
                                      { const u32x2 en_ = tglist[((size_t)lo * 32 + e) * 512 + (g - pfx[lo * 32 + e])]; dv[k] = (int)en_.x; gb[k] = en_.y; } okv[k] = true; } } }
                          float gv[4];
                          _Pragma("unroll") for (int k = 0; k < 4; ++k) gv[k] = okv[k] ? __builtin_bit_cast(float, gb[k]) : 0.f;
                          _Pragma("unroll") for (int k = 0; k < 4; ++k) if (inr[k]) { if (base == 0 && k == 0 && tid < 256) ((LAS int*)(lds + BIAS_OFF))[tid] = okv[k] ? (dv[k] >> 2) : 0;     row_tok[rowv[k]] = okv[k] ? (dv[k] >> 2) : 0; row_dst[rowv[k]] = okv[k] ? dv[k] : -1; row_gate[rowv[k]] = gv[k]; } }
                      __syncthreads(); }
                    pg8::gemm_phase<pg8::EpiMoe1, pg8::MoeSched<true>, true>(lds, DM / 2, S, E);
                    if (cvb) { const int nl = T >= R * Ge ? Ge : T - (R - 1) * Ge; HOST_NOTE(); cv_limit = 2 * CNIT; cv_thr = HOST_THR(2, nl); } }
                } else { if constexpr (HAS(13)) {
                    pg8::MoeSched<false> S; S.tok0 = nullptr; S.A = (const char*)(ws + WS_H); S.B = (const char*)(ws + WS_WD + (size_t)l * NE * DM * DM); S.lda = DM / 2; S.ldb = DM / 2; S.b_es = (size_t)DM * DM; S.nN = 4; S.n_mt = n_mt; S.mt_e = mt_e; S.row_tok = nullptr;
                    const int T = 4 * n_mt, R = (T + G - 1) / G; int kc = 0;
                    if (l == 0 && (G & 7) == 0 && G >= 64) { kc = (((R * G - T) + R - 1) / R + 7) & ~7; kc = kc > 32 ? 32 : kc; }
                    const int Ge = G - kc, Lmain = T < R * Ge ? T : R * Ge; const bool cvb = bid >= Ge;
                    S.G = cvb ? kc : Ge; S.c = cvb ? bid - Ge : bid; S.L0 = cvb ? Lmain : 0; S.Lend = cvb ? T : Lmain;
                    S.note = (l == 0 && !cvb) ? (unsigned long long*)((unsigned*)(ws + WS_CTL) + CQ_WORD) : nullptr;
                    pg8::EpiMoe2 E{(const int*)(ws + WS_ROWDST), (const float*)(ws + WS_ROWGATE), a.in[I_EBD + zq] + (size_t)l * NE * DM, ws + WS_SLAB, PROBE_DRY && probe_rep > 0, lds};
                    pg8::gemm_phase<pg8::EpiMoe2, pg8::MoeSched<false>, true>(lds, DM / 2, S, E);
                    if (cvb) { const int nl = T >= R * Ge ? Ge : T - (R - 1) * Ge; HOST_NOTE(); cv_limit = 2 * CNIT; cv_thr = HOST_THR(3, nl); } }
                }
            } }
        }
        _Pragma("unroll 1") for (int pass = 0; pass < 2; ++pass) {
        if constexpr (HAS(0)) { if (ph == 0 && pass == 1 - ((bid >> 3) & 1)) { __syncthreads(); for (int u = bid; u < NLAYER * 16 * 8; u += G) ssm_stage1(a, zq, u, lds, tid); __syncthreads(); } }
        if (pass == 0) {
        if (cs_end) { int cs0 = cs_lo;
            if (cs_lo < 0) { const unsigned h = __hip_atomic_load((unsigned*)(ws + WS_CTL) + CQ_WORD, __ATOMIC_RELAXED, __HIP_MEMORY_SCOPE_AGENT); cs0 = CONV_P0N + 16 * (int)(h < (unsigned)CNIT ? h : (unsigned)CNIT); }
            __syncthreads(); conv_static(a, zq, cs0, cs_end, cs_w0, cs_nw, (LAS float*)(lds + wave * 16640), lane); }
        if (cv_limit) { __syncthreads(); conv_pull(a, zq, cv_limit, cv_thr, cv_thr != 0u, lds, tid, wave, lane); } } }
#if MK_N_LAUNCHES
        const int pcode = ph == 0 ? 0 : ph == N_PHASES ? 14 : 1 + sp_of(ph);
        const bool again = (pcode == PROBE_CODE) && (!PROBE_L0ONLY || ph <= PH_PER_LAYER) && (probe_rep < PROBE_REPS);
        if (ph + 1 < a.ph_hi || again) xcd_barrier(bar);
        if (again) ++probe_rep; else { probe_rep = 0; ++ph; }
#else
        ++ph;
#endif
    }
}
__global__ void __launch_bounds__(NTHR, 2) mk_final(Args a) {
    const int tid = threadIdx.x, lane = tid & 63, wave = tid >> 6;
    const int zq = 0; xprep(a, zq, 2, blockIdx.x * NWAVES + wave, gridDim.x * NWAVES, lane);
}

typedef void (*kern_t)(Args);
static kern_t phase_kernel(int code) {
    switch (code) {
        case 0: return mk<1u << 0>; case 1: return mk<1u << 1>; case 2: return mk<1u << 2>; case 3: return mk<1u << 3>; case 4: return mk<1u << 4>; case 5: return mk<1u << 5>; case 6: return mk<1u << 6>;
        case 7: return mk<1u << 7>; case 8: return mk<1u << 8>; case 9: return mk<1u << 9>; case 10: return mk<1u << 10>; case 11: return mk<1u << 11>; case 12: return mk<1u << 12>; default: return mk<1u << 13>;
    }
}
static bool set_lds_all() {
#if MK_N_LAUNCHES == 1
    return hipFuncSetAttribute((const void*)mk<0x777fu>, hipFuncAttributeMaxDynamicSharedMemorySize, LDS_BYTES) == hipSuccess;
#endif
    for (int c = 0; c < 14; ++c) if (hipFuncSetAttribute((const void*)phase_kernel(c), hipFuncAttributeMaxDynamicSharedMemorySize, LDS_BYTES) != hipSuccess) return false; return true; }
static void launch_phase(int code, int grid, hipStream_t stream, const Args& a) { hipLaunchKernelGGL(phase_kernel(code), dim3(grid), dim3(NTHR), LDS_BYTES, stream, a); }
extern "C" void kernel_launch(void* const* d_in, const int* in_sizes, int n_in, void* d_out, int out_size, void* d_ws, size_t ws_size, hipStream_t stream) {
    static int grid = 0;
    if (grid == 0) {
        if (n_in != 36 || out_size != NTOK * DM || ws_size < WS_END) { fprintf(stderr, "kernel_launch: unexpected problem (n_in %d out %d ws %zu, need %zu)\n", n_in, out_size, ws_size, (size_t)WS_END); grid = -1; return; }
        int dev = 0, cus = 0;
        if (hipGetDevice(&dev) != hipSuccess || hipDeviceGetAttribute(&cus, hipDeviceAttributeMultiprocessorCount, dev) != hipSuccess) { grid = -1; return; }
        if (!set_lds_all()) { fprintf(stderr, "kernel_launch: hipFuncSetAttribute failed\n"); grid = -1; return; }
        (void)hipGetLastError();
        int per_cu = 0;
#if MK_N_LAUNCHES == 1
        if (hipOccupancyMaxActiveBlocksPerMultiprocessor(&per_cu, (const void*)mk<0x777fu>, NTHR, LDS_BYTES) != hipSuccess || per_cu < 1) { fprintf(stderr, "kernel_launch: the kernel does not fit a CU (occupancy %d)\n", per_cu); grid = -1; return; }
#endif
        grid = cus;
    }
    if (grid < 0) return;
    (void)hipMemsetAsync((char*)d_ws + WS_CTL, 0, CTL_ZERO_BYTES, stream);
    Args a{};
    for (int i = 0; i < 36; ++i) a.in[i] = (const float*)d_in[i];
    a.out = (float*)d_out; a.ws = (unsigned char*)d_ws;
#if MK_N_LAUNCHES == 1
    a.ph_lo = 0; a.ph_hi = N_PHASES + 1;
    void* kargs[] = {(void*)&a};
    hipError_t e = hipLaunchCooperativeKernel((const void*)mk<0x777fu>, dim3(grid), dim3(NTHR), kargs, LDS_BYTES, stream);
    if (e != hipSuccess) fprintf(stderr, "kernel_launch: cooperative launch failed: %s (grid %d)\n", hipGetErrorString(e), grid);
#else
    for (int ph = 0; ph < N_PHASES; ++ph) { a.ph_lo = ph; a.ph_hi = ph + 1; launch_phase(ph == 0 ? 0 : 1 + sp_of(ph), grid, stream, a); }
    a.ph_lo = 0; a.ph_hi = 0;
    hipLaunchKernelGGL(mk_final, dim3(grid), dim3(NTHR), 0, stream, a);
#endif
}
```
